# Optimizing an MI355X kernel written in HIP

```python
import math
import jax
import jax.numpy as jnp
from jax import lax
import numpy as np

D_MODEL = 1024
BATCH = 8
SEQ = 2048
DEPTH = 4

GRID_W = 64
CTX_LEN = 256
HEAD_DIM = 64
NORM_EPS = 1e-6

SSD_HEADS = 16
SSD_HEAD_DIM = 64
SSD_INNER = SSD_HEADS * SSD_HEAD_DIM
SSD_GROUPS = 2
SSD_STATE = 128
SSD_CONV = 5
SSD_CHUNK = 128
SSD_XBC = SSD_INNER + 2 * SSD_GROUPS * SSD_STATE

SWA_Q_HEADS = 8
SWA_KV_HEADS = 2
SWA_WINDOW = 128
SWA_BLOCK = 128
SWA_Q = SWA_Q_HEADS * HEAD_DIM
SWA_KV = SWA_KV_HEADS * HEAD_DIM
ROPE_THETA = 10000.0

NA_HEADS = 8
NA_WIN_R = 8
NA_WIN_C = 16
NA_DIM = NA_HEADS * HEAD_DIM

N_BRANCH = 3
IN_SIZES = (SSD_INNER, SSD_XBC, SSD_HEADS, SSD_HEADS, SWA_Q, SWA_KV, SWA_KV, NA_DIM, NA_DIM, NA_DIM, N_BRANCH * D_MODEL)
IN_COLS = SSD_INNER + SSD_XBC + 2 * SSD_HEADS + SWA_Q + 2 * SWA_KV + 3 * NA_DIM + N_BRANCH * D_MODEL

N_EXPERTS = 32
TOP_K = 4
D_EXPERT = D_MODEL
SWIGLU_LIMIT = 7.0
SWIGLU_ALPHA = 1.702
MOE_BLOCK = 128

kernel_name = 'hybrid_ssd_swa_natten_moe_diffusion_trunk'


def rmsnorm(x, g):
    xf = x.astype(jnp.float32)
    y = xf * lax.rsqrt(jnp.mean(xf * xf, axis=-1, keepdims=True) + NORM_EPS)
    return (y * g.astype(jnp.float32)).astype(x.dtype)


def split_cols(t):
    idx = np.cumsum(np.array(IN_SIZES))[:-1].tolist()
    return jnp.split(t, idx, axis=-1)


def to_heads(t, n):
    return t.reshape(t.shape[0], t.shape[1], n, HEAD_DIM)


def rope_axis(u, pos):
    d = u.shape[-1]
    inv = ROPE_THETA ** (-jnp.arange(0, d, 2, dtype=jnp.float32) / d)
    ang = pos.astype(jnp.float32)[:, None] * inv[None, :]
    cos = jnp.cos(ang)[None, :, None, :]
    sin = jnp.sin(ang)[None, :, None, :]
    uf = u.astype(jnp.float32)
    u1, u2 = uf[..., : d // 2], uf[..., d // 2:]
    return jnp.concatenate([u1 * cos - u2 * sin, u2 * cos + u1 * sin], axis=-1).astype(u.dtype)


def rope_2d(t, row, col):
    half = t.shape[-1] // 2
    return jnp.concatenate([rope_axis(t[..., :half], row), rope_axis(t[..., half:], col)], axis=-1)


def dwconv_centred(u, w, b):
    pad = w.shape[0] // 2
    y = lax.conv_general_dilated(u, w[:, None, :].astype(u.dtype), window_strides=(1,), padding=[(pad, pad)],
                                 dimension_numbers=('NWC', 'WIO', 'NWC'), feature_group_count=u.shape[-1])
    return y + b


def segsum(a):
    t = a.shape[-1]
    cs = jnp.cumsum(a, axis=-1)
    d = cs[..., :, None] - cs[..., None, :]
    mask = jnp.tril(jnp.ones((t, t), dtype=bool))
    return jnp.where(mask, d, -jnp.inf)


def ssd_scan(x, dt, a_coef, bm, cm, h0):
    b, l, h, p = x.shape
    g, n = bm.shape[2], bm.shape[3]
    hg = h // g
    q = SSD_CHUNK
    nc = l // q
    f32 = jnp.float32
    xf = (x.astype(f32) * dt[..., None]).reshape(b, nc, q, g, hg, p)
    a = jnp.moveaxis((dt * a_coef.astype(f32)).reshape(b, nc, q, g, hg), 2, -1)
    a_cs = jnp.cumsum(a, axis=-1)
    bc = bm.astype(f32).reshape(b, nc, q, g, n)
    cc = cm.astype(f32).reshape(b, nc, q, g, n)
    lmat = jnp.exp(segsum(a))
    cb = jnp.einsum('bclgn,bcsgn->bcgls', cc, bc)
    y_diag = jnp.einsum('bcgjls,bcsgjp->bclgjp', cb[:, :, :, None] * lmat, xf)
    decay_states = jnp.exp(a_cs[..., -1:] - a_cs)
    states = jnp.einsum('bcsgn,bcgjs,bcsgjp->bcgjpn', bc, decay_states, xf)
    states = jnp.concatenate([h0.astype(f32).reshape(b, 1, g, hg, p, n), states], axis=1)
    chunk_a = jnp.pad(a_cs[..., -1], ((0, 0), (1, 0), (0, 0), (0, 0)))
    decay_chunk = jnp.exp(segsum(jnp.moveaxis(chunk_a, 1, -1)))
    new_states = jnp.einsum('bgjzc,bcgjpn->bzgjpn', decay_chunk, states)
    prev_states, final = new_states[:, :-1], new_states[:, -1]
    y_off = jnp.einsum('bclgn,bcgjpn,bcgjl->bclgjp', cc, prev_states, jnp.exp(a_cs))
    y = (y_diag + y_off).reshape(b, l, h, p)
    return y, final.reshape(b, h, p, n)


def ssd_branch(z, xbc, dtf_raw, dtb_raw, p, h0_f, h0_b):
    bsz, l, _ = z.shape
    f32 = jnp.float32
    xbc = jax.nn.silu(dwconv_centred(xbc, p['ssd_conv_w'], p['ssd_conv_b']))
    xs = xbc[..., :SSD_INNER].reshape(bsz, l, SSD_HEADS, SSD_HEAD_DIM)
    bm = xbc[..., SSD_INNER:SSD_INNER + SSD_GROUPS * SSD_STATE].reshape(bsz, l, SSD_GROUPS, SSD_STATE)
    cm = xbc[..., SSD_INNER + SSD_GROUPS * SSD_STATE:].reshape(bsz, l, SSD_GROUPS, SSD_STATE)
    a_log = p['ssd_a_log'].astype(f32)
    dt_bias = p['ssd_dt_bias'].astype(f32)
    dt_f = jax.nn.softplus(dtf_raw.astype(f32) + dt_bias[0])
    dt_b = jax.nn.softplus(dtb_raw.astype(f32) + dt_bias[1])
    y_f, hf = ssd_scan(xs, dt_f, -jnp.exp(a_log[0]), bm, cm, h0_f)
    rev = lambda t: jnp.flip(t, axis=1)
    y_b, hb = ssd_scan(rev(xs), rev(dt_b), -jnp.exp(a_log[1]), rev(bm), rev(cm), h0_b)
    y = y_f + rev(y_b) + p['ssd_d'].astype(f32)[:, None] * xs.astype(f32)
    y = y.reshape(bsz, l, SSD_INNER) * jax.nn.silu(z.astype(f32))
    return rmsnorm(y, p['ssd_norm_g']).astype(z.dtype), hf, hb


def swa_latent(q, k, v, kc, vc, sink):
    bsz, s, hq, d = q.shape
    hkv = k.shape[2]
    g = hq // hkv
    blk = SWA_BLOCK
    nb = s // blk
    lc = kc.shape[1]
    scale = d ** -0.5
    qb = q.reshape(bsz, nb, blk, hkv, g, d)

    def band(t):
        tp = jnp.pad(t, ((0, 0), (blk, blk), (0, 0), (0, 0))).reshape(bsz, nb + 2, blk, hkv, d)
        return jnp.concatenate([tp[:, :-2], tp[:, 1:-1], tp[:, 2:]], axis=2)

    kb, vb = band(k), band(v)
    s_loc = jnp.einsum('bnqhgd,bnjhd->bnhgqj', qb, kb).astype(jnp.float32) * scale
    qi = jnp.arange(blk)[None, :, None]
    kj = jnp.arange(3 * blk)[None, None, :]
    nidx = jnp.arange(nb)[:, None, None]
    kpos = nidx * blk - blk + kj
    qpos = nidx * blk + qi
    mask = (jnp.abs(kpos - qpos) <= SWA_WINDOW) & (kpos >= 0) & (kpos < s)
    s_loc = jnp.where(mask[None, :, None, None], s_loc, -jnp.inf)
    s_ctx = jnp.einsum('bnqhgd,bchd->bnhgqc', qb, kc).astype(jnp.float32) * scale
    s_sink = jnp.broadcast_to(sink.astype(jnp.float32).reshape(hkv, g)[None, None, :, :, None, None],
                              s_loc.shape[:-1] + (1,))
    prob = jax.nn.softmax(jnp.concatenate([s_loc, s_ctx, s_sink], axis=-1), axis=-1)
    p_loc = prob[..., : 3 * blk].astype(v.dtype)
    p_ctx = prob[..., 3 * blk: 3 * blk + lc].astype(v.dtype)
    o = jnp.einsum('bnhgqj,bnjhd->bnqhgd', p_loc, vb) + jnp.einsum('bnhgqc,bchd->bnqhgd', p_ctx, vc)
    return o.reshape(bsz, s, hq * d)


def na_latent(q, k, v, kc, vc, rpb):
    bsz, s, h, d = q.shape
    rows = s // GRID_W
    wr = min(NA_WIN_R, rows)
    wc = NA_WIN_C
    scale = d ** -0.5
    r = jnp.arange(rows)
    cidx = jnp.arange(GRID_W)
    r0 = jnp.clip(r - wr // 2, 0, rows - wr)
    c0 = jnp.clip(cidx - wc // 2, 0, GRID_W - wc)
    krow = r0[:, None] + jnp.arange(wr)[None, :]
    q4 = q.reshape(bsz, rows, GRID_W, h, d)
    k4 = k.reshape(bsz, rows, GRID_W, h, d)[:, krow]
    v4 = v.reshape(bsz, rows, GRID_W, h, d)[:, krow]
    sc = jnp.einsum('brqhd,brikhd->bhrqik', q4, k4).astype(jnp.float32) * scale
    roff = krow - r[:, None] + (NA_WIN_R - 1)
    coff = jnp.clip(cidx[None, :] - cidx[:, None] + (NA_WIN_C - 1), 0, 2 * NA_WIN_C - 2)
    cvalid = (cidx[None, :] >= c0[:, None]) & (cidx[None, :] < c0[:, None] + wc)
    bias = rpb.astype(jnp.float32)[:, roff[:, None, :, None], coff[None, :, None, :]]
    sc = jnp.where(cvalid[:, None, :], sc + bias[None], -jnp.inf)
    s_ctx = jnp.einsum('brqhd,bchd->bhrqc', q4, kc).astype(jnp.float32) * scale
    nk = wr * GRID_W
    prob = jax.nn.softmax(jnp.concatenate([sc.reshape(bsz, h, rows, GRID_W, nk), s_ctx], axis=-1), axis=-1)
    p_loc = prob[..., :nk].reshape(bsz, h, rows, GRID_W, wr, GRID_W).astype(v.dtype)
    p_ctx = prob[..., nk:].astype(v.dtype)
    o = jnp.einsum('bhrqik,brikhd->brqhd', p_loc, v4) + jnp.einsum('bhrqc,bchd->brqhd', p_ctx, vc)
    return o.reshape(bsz, s, h * d)


def ctx_attention(qc, kc, vc, sink=None):
    bsz, lc, hq, d = qc.shape
    hkv = kc.shape[2]
    g = hq // hkv
    qg = qc.reshape(bsz, lc, hkv, g, d)
    s = jnp.einsum('bqhgd,bkhd->bhgqk', qg, kc).astype(jnp.float32) * d ** -0.5
    if sink is None:
        prob = jax.nn.softmax(s, axis=-1)
    else:
        s_sink = jnp.broadcast_to(sink.astype(jnp.float32).reshape(hkv, g)[None, :, :, None, None], s.shape[:-1] + (1,))
        prob = jax.nn.softmax(jnp.concatenate([s, s_sink], axis=-1), axis=-1)[..., :-1]
    o = jnp.einsum('bhgqk,bkhd->bqhgd', prob.astype(vc.dtype), vc)
    return o.reshape(bsz, lc, hq * d)


def merge(o_ssd, o_swa, o_na, g, p):
    gates = jax.nn.sigmoid((g + p['b_gate']).astype(jnp.float32)).astype(o_ssd.dtype)
    ga, gb, gn = jnp.split(gates, N_BRANCH, axis=-1)
    m = ga * (o_ssd @ p['w_br_ssd']) + gb * (o_swa @ p['w_br_swa']) + gn * (o_na @ p['w_br_na'])
    return m @ p['w_out']


def moe(hid, p):
    t, d = hid.shape
    logits = (hid @ p['router_w']).astype(jnp.float32) + p['router_b'].astype(jnp.float32)
    top_v, top_i = lax.top_k(logits, TOP_K)
    gates = jax.nn.softmax(top_v, axis=-1)
    flat_e = top_i.reshape(-1)
    flat_tok = jnp.repeat(jnp.arange(t, dtype=jnp.int32), TOP_K)
    flat_w = gates.reshape(-1)
    order = jnp.argsort(flat_e)
    se = flat_e[order]
    counts = jnp.bincount(flat_e, length=N_EXPERTS)
    starts = jnp.cumsum(counts) - counts
    padded = (counts + MOE_BLOCK - 1) // MOE_BLOCK * MOE_BLOCK
    pends = jnp.cumsum(padded)
    pstarts = pends - padded
    slot = pstarts[se] + (jnp.arange(t * TOP_K) - starts[se])
    n_blocks = (t * TOP_K + MOE_BLOCK - 1) // MOE_BLOCK + N_EXPERTS
    n_slots = n_blocks * MOE_BLOCK
    slot_tok = jnp.zeros((n_slots,), jnp.int32).at[slot].set(flat_tok[order])
    slot_w = jnp.zeros((n_slots,), jnp.float32).at[slot].set(flat_w[order])
    block_e = jnp.clip(jnp.searchsorted(pends, jnp.arange(n_blocks) * MOE_BLOCK, side='right'), 0, N_EXPERTS - 1)
    xs = hid[slot_tok].reshape(n_blocks, MOE_BLOCK, d)
    w1, b1, w2, b2 = p['moe_w1'], p['moe_b1'], p['moe_w2'], p['moe_b2']

    def expert_block(args):
        xb, e = args
        gu = xb @ w1[e] + b1[e]
        gate = jnp.minimum(gu[:, :D_EXPERT], SWIGLU_LIMIT)
        up = jnp.clip(gu[:, D_EXPERT:], -SWIGLU_LIMIT, SWIGLU_LIMIT)
        act = (up + 1) * gate * jax.nn.sigmoid(SWIGLU_ALPHA * gate)
        return act @ w2[e] + b2[e]

    ys = lax.map(expert_block, (xs, block_e)).reshape(n_slots, d)
    ys = ys * slot_w[:, None].astype(ys.dtype)
    return jax.ops.segment_sum(ys, slot_tok, num_segments=t)


def layer(xl, xc, sc_l, sc_c, row, col, p, last):
    bsz, s, d = xl.shape
    lc = xc.shape[1]
    mod_l = (sc_l @ p['w_ada'] + p['b_ada'])[:, None, :]
    mod_c = sc_c @ p['w_ada'] + p['b_ada']
    sh1_l, s1_l, g1_l, sh2_l, s2_l, g2_l = jnp.split(mod_l, 6, axis=-1)
    sh1_c, s1_c, g1_c, sh2_c, s2_c, g2_c = jnp.split(mod_c, 6, axis=-1)

    hl = rmsnorm(xl, p['norm1_g']) * (1 + s1_l) + sh1_l
    hc = rmsnorm(xc, p['norm1_g']) * (1 + s1_c) + sh1_c
    zl, xbcl, dtfl, dtbl, qsl, ksl, vsl, qnl, knl, vnl, gl = split_cols(hl @ p['w_in'])
    zc, xbcc, dtfc, dtbc, qsc, ksc, vsc, qnc, knc, vnc, gc = split_cols(hc @ p['w_in'])

    h0 = jnp.zeros((bsz, SSD_HEADS, SSD_HEAD_DIM, SSD_STATE), jnp.float32)
    ssd_c, hf, hb = ssd_branch(zc, xbcc, dtfc, dtbc, p, h0, h0)
    ssd_l, _, _ = ssd_branch(zl, xbcl, dtfl, dtbl, p, hf, hb)

    ks_c, vs_c = to_heads(ksc, SWA_KV_HEADS), to_heads(vsc, SWA_KV_HEADS)
    swa_l = swa_latent(rope_2d(to_heads(qsl, SWA_Q_HEADS), row, col), rope_2d(to_heads(ksl, SWA_KV_HEADS), row, col),
                       to_heads(vsl, SWA_KV_HEADS), ks_c, vs_c, p['swa_sink'])

    kn_c, vn_c = to_heads(knc, NA_HEADS), to_heads(vnc, NA_HEADS)
    na_l = na_latent(to_heads(qnl, NA_HEADS), to_heads(knl, NA_HEADS), to_heads(vnl, NA_HEADS), kn_c, vn_c, p['na_rpb'])

    xl = xl + g1_l * merge(ssd_l, swa_l, na_l, gl, p)
    if not last:
        swa_c = ctx_attention(to_heads(qsc, SWA_Q_HEADS), ks_c, vs_c, p['swa_sink'])
        na_c = ctx_attention(to_heads(qnc, NA_HEADS), kn_c, vn_c)
        xc = xc + g1_c * merge(ssd_c, swa_c, na_c, gc, p)

    fl = rmsnorm(xl, p['norm2_g']) * (1 + s2_l) + sh2_l
    if last:
        yl = moe(fl.reshape(bsz * s, d), p).reshape(bsz, s, d)
    else:
        fc = rmsnorm(xc, p['norm2_g']) * (1 + s2_c) + sh2_c
        y = moe(jnp.concatenate([fc.reshape(bsz * lc, d), fl.reshape(bsz * s, d)], axis=0), p)
        xc = xc + g2_c * y[: bsz * lc].reshape(bsz, lc, d)
        yl = y[bsz * lc:].reshape(bsz, s, d)
    xl = xl + g2_l * yl
    return xl, xc


def setup_inputs(seed: int = 0) -> dict:
    key = jax.random.key(seed)
    keys = jax.random.split(key, 32)
    ctr = [0]

    def nxt():
        ctr[0] += 1
        return keys[ctr[0] - 1]

    def nrm(shape, scale):
        return jax.random.normal(nxt(), shape, jnp.float32) * scale

    L, D = DEPTH, D_MODEL
    x = nrm((BATCH, SEQ, D), 1.0)
    c = nrm((BATCH, D), 1.0)
    ctx = nrm((BATCH, CTX_LEN, D), 1.0)
    c_ctx = nrm((D,), 1.0)
    norm1_g = 1.0 + nrm((L, D), 0.05)
    norm2_g = 1.0 + nrm((L, D), 0.05)
    w_ada = nrm((L, D, 6 * D), 0.5 * D ** -0.5)
    b_ada = nrm((L, 6 * D), 0.01)
    w_in = nrm((L, D, IN_COLS), D ** -0.5)
    b_gate = nrm((L, N_BRANCH * D), 0.01)
    ssd_conv_w = nrm((L, SSD_CONV, SSD_XBC), SSD_CONV ** -0.5)
    ssd_conv_b = nrm((L, SSD_XBC), 0.01)
    ssd_a_log = jnp.log(jax.random.uniform(nxt(), (L, 2, SSD_HEADS), jnp.float32, 1.0, 16.0))
    dt0 = jnp.exp(jax.random.uniform(nxt(), (L, 2, SSD_HEADS), jnp.float32, math.log(1e-3), math.log(1e-1)))
    ssd_dt_bias = dt0 + jnp.log(-jnp.expm1(-dt0))
    ssd_d = 1.0 + nrm((L, SSD_HEADS), 0.1)
    ssd_norm_g = 1.0 + nrm((L, SSD_INNER), 0.05)
    swa_sink = nrm((L, SWA_Q_HEADS), 0.5)
    na_rpb = nrm((L, NA_HEADS, 2 * NA_WIN_R - 1, 2 * NA_WIN_C - 1), 0.1)
    w_br_ssd = nrm((L, SSD_INNER, D), SSD_INNER ** -0.5)
    w_br_swa = nrm((L, SWA_Q, D), SWA_Q ** -0.5)
    w_br_na = nrm((L, NA_DIM, D), NA_DIM ** -0.5)
    w_out = nrm((L, D, D), D ** -0.5)
    router_w = nrm((L, D, N_EXPERTS), D ** -0.5)
    router_b = nrm((L, N_EXPERTS), 0.01)
    moe_w1 = nrm((L, N_EXPERTS, D, 2 * D_EXPERT), D ** -0.5)
    moe_b1 = nrm((L, N_EXPERTS, 2 * D_EXPERT), 0.01)
    moe_w2 = nrm((L, N_EXPERTS, D_EXPERT, D), D_EXPERT ** -0.5)
    moe_b2 = nrm((L, N_EXPERTS, D), 0.01)
    final_norm_g = 1.0 + nrm((D,), 0.05)
    return {'x': x, 'c': c, 'ctx': ctx, 'c_ctx': c_ctx, 'norm1_g': norm1_g, 'norm2_g': norm2_g,
            'w_ada': w_ada, 'b_ada': b_ada, 'w_in': w_in, 'b_gate': b_gate,
            'ssd_conv_w': ssd_conv_w, 'ssd_conv_b': ssd_conv_b, 'ssd_a_log': ssd_a_log,
            'ssd_dt_bias': ssd_dt_bias, 'ssd_d': ssd_d, 'ssd_norm_g': ssd_norm_g,
            'swa_sink': swa_sink, 'na_rpb': na_rpb, 'w_br_ssd': w_br_ssd, 'w_br_swa': w_br_swa,
            'w_br_na': w_br_na, 'w_out': w_out, 'router_w': router_w, 'router_b': router_b,
            'moe_w1': moe_w1, 'moe_b1': moe_b1, 'moe_w2': moe_w2, 'moe_b2': moe_b2,
            'final_norm_g': final_norm_g}


def reference(x, c, ctx, c_ctx, norm1_g, norm2_g, w_ada, b_ada, w_in, b_gate, ssd_conv_w, ssd_conv_b,
              ssd_a_log, ssd_dt_bias, ssd_d, ssd_norm_g, swa_sink, na_rpb, w_br_ssd, w_br_swa, w_br_na,
              w_out, router_w, router_b, moe_w1, moe_b1, moe_w2, moe_b2, final_norm_g):
    s = x.shape[1]
    pos = jnp.arange(s)
    row, col = pos // GRID_W, pos % GRID_W
    sc_l = jax.nn.silu(c)
    sc_c = jax.nn.silu(c_ctx)
    xl, xc = x, ctx
    for i in range(DEPTH):
        p = {'norm1_g': norm1_g[i], 'norm2_g': norm2_g[i], 'w_ada': w_ada[i], 'b_ada': b_ada[i],
             'w_in': w_in[i], 'b_gate': b_gate[i], 'ssd_conv_w': ssd_conv_w[i], 'ssd_conv_b': ssd_conv_b[i],
             'ssd_a_log': ssd_a_log[i], 'ssd_dt_bias': ssd_dt_bias[i], 'ssd_d': ssd_d[i],
             'ssd_norm_g': ssd_norm_g[i], 'swa_sink': swa_sink[i], 'na_rpb': na_rpb[i],
             'w_br_ssd': w_br_ssd[i], 'w_br_swa': w_br_swa[i], 'w_br_na': w_br_na[i], 'w_out': w_out[i],
             'router_w': router_w[i], 'router_b': router_b[i], 'moe_w1': moe_w1[i], 'moe_b1': moe_b1[i],
             'moe_w2': moe_w2[i], 'moe_b2': moe_b2[i]}
        xl, xc = layer(xl, xc, sc_l, sc_c, row, col, p, i == DEPTH - 1)
    return rmsnorm(xl, final_norm_g)
```

```cpp
#ifndef HOST_EMU
#include <hip/hip_runtime.h>
#include <cstdio>
#include <cstdint>
#define HD __host__ __device__ __forceinline__
#else
#include <cstdio>
#include <cstdint>
#include <cstring>
#include <cmath>
#include <cstdlib>
#define HD inline
struct uint4 { unsigned x, y, z, w; };
struct float4 { float x, y, z, w; };
#endif

typedef unsigned short bf16;

#ifdef HOST_EMU
static int NB = 2, NL = 2;
#else
constexpr int NB = 8, NL = 4;
#endif
constexpr int S = 2048, LC = 256, D = 1024, GW = 64;
constexpr int NPROJ = 7936, NPAD = 8192;
constexpr int PC_Z = 0, PC_XBC = 1024, PC_QS = 2560, PC_KS = 3072, PC_VS = 3200, PC_QN = 3328, PC_KN = 3840, PC_VN = 4352, PC_G = 4864;
constexpr int NE = 32, TOPK = 4;
constexpr float NORM_EPS = 1e-6f;
#define TL (NB * S)
#define TC (NB * LC)
#define TT (TL + TC)
#define NSLOT (TT * 4 + NE * 256)

struct P {
    const float *x, *c, *ctx, *c_ctx, *norm1_g, *norm2_g, *w_ada, *b_ada, *w_in, *b_gate, *conv_w, *conv_b, *a_log, *dt_bias, *ssd_d, *ssd_norm_g,
        *swa_sink, *na_rpb, *w_br_ssd, *w_br_swa, *w_br_na, *w_out, *router_w, *router_b, *moe_w1, *moe_b1, *moe_w2, *moe_b2, *final_g;
    float* out;
    unsigned* ctl;
    float *xl, *mod, *dt, *yf, *yb, *macc, *topw;
    bf16 *h, *proj, *xa, *qsr, *ksr, *ossd, *oswa, *ona, *m, *xs, *act, *ys;
    int *topi, *slot_of, *cnt, *cursor, *pstart, *nunits, *slot_tok, *units1, *units2;
    bf16 *w_in_t, *w_ssd_t, *w_swa_t, *w_na_t, *w_out_t, *w1_t, *w2_t;
};

static size_t carve_ws(P& p, char* base) {
    size_t off = 0;
    auto take = [&](size_t bytes) { char* r = base ? base + off : nullptr; off += (bytes + 4095) & ~(size_t)4095; return r; };
    p.ctl = (unsigned*)take(1 << 20);
    p.xl = (float*)take((size_t)TT * D * 4); p.mod = (float*)take((size_t)NL * (NB + 1) * 6 * D * 4); p.dt = (float*)take((size_t)TT * 32 * 4);
    p.yf = (float*)take((size_t)TT * 1024 * 4); p.yb = (float*)take((size_t)TT * 1024 * 4); p.macc = (float*)take((size_t)TT * D * 4); p.topw = (float*)take((size_t)TT * 4 * 4);
    p.h = (bf16*)take((size_t)TT * D * 2); p.proj = (bf16*)take((size_t)TT * NPROJ * 2); p.xa = (bf16*)take((size_t)TT * 1536 * 2);
    p.qsr = (bf16*)take((size_t)TL * 512 * 2); p.ksr = (bf16*)take((size_t)TL * 128 * 2);
    p.ossd = (bf16*)take((size_t)TT * 1024 * 2); p.oswa = (bf16*)take((size_t)TT * 512 * 2); p.ona = (bf16*)take((size_t)TT * 512 * 2); p.m = (bf16*)take((size_t)TT * D * 2);
    p.xs = (bf16*)take((size_t)NSLOT * D * 2); p.act = (bf16*)take((size_t)NSLOT * D * 2); p.ys = (bf16*)take((size_t)NSLOT * D * 2);
    p.topi = (int*)take((size_t)TT * 4 * 4); p.slot_of = (int*)take((size_t)TT * 4 * 4); p.cnt = (int*)take(4096); p.cursor = (int*)take(4096); p.pstart = (int*)take(4096); p.nunits = (int*)take(4096);
    p.slot_tok = (int*)take((size_t)NSLOT * 4); p.units1 = (int*)take((size_t)(NSLOT / 256) * 8 * 4); p.units2 = (int*)take((size_t)(NSLOT / 256) * 4 * 4);
    p.w_in_t = (bf16*)take((size_t)NL * NPAD * D * 2); p.w_ssd_t = (bf16*)take((size_t)NL * D * 1024 * 2); p.w_swa_t = (bf16*)take((size_t)NL * D * 512 * 2); p.w_na_t = (bf16*)take((size_t)NL * D * 512 * 2);
    p.w_out_t = (bf16*)take((size_t)NL * D * D * 2); p.w1_t = (bf16*)take((size_t)NL * NE * 2048 * D * 2); p.w2_t = (bf16*)take((size_t)NL * NE * D * D * 2);
    return off;
}
static void bind_inputs(P& p, void* const* d_in, void* d_out) {
    const float** f = (const float**)&p.x;
    for (int i = 0; i < 29; ++i) f[i] = (const float*)d_in[i];
    p.out = (float*)d_out;
}

HD unsigned f2u(float f) { unsigned u; __builtin_memcpy(&u, &f, 4); return u; }
HD float u2f(unsigned u) { float f; __builtin_memcpy(&f, &u, 4); return f; }
HD bf16 f2bf(float f) { unsigned u = f2u(f); return (bf16)((u + 0x7fffu + ((u >> 16) & 1u)) >> 16); }
HD float bf2f(bf16 b) { return u2f(((unsigned)b) << 16); }
HD unsigned pk2(float lo, float hi) { return (unsigned)f2bf(lo) | ((unsigned)f2bf(hi) << 16); }
HD float sigmoidf_(float x) { return 1.f / (1.f + expf(-x)); }
HD float siluf_(float x) { return x / (1.f + expf(-x)); }
HD float softplusf_(float x) { return x > 20.f ? x : log1pf(expf(x)); }
HD void ld8(const bf16* p, float* o) {
    const uint4 v = *(const uint4*)p;
    o[0] = u2f(v.x << 16); o[1] = u2f(v.x & 0xffff0000u); o[2] = u2f(v.y << 16); o[3] = u2f(v.y & 0xffff0000u);
    o[4] = u2f(v.z << 16); o[5] = u2f(v.z & 0xffff0000u); o[6] = u2f(v.w << 16); o[7] = u2f(v.w & 0xffff0000u);
}
HD void st8(bf16* p, const float* v) { uint4 o; o.x = pk2(v[0], v[1]); o.y = pk2(v[2], v[3]); o.z = pk2(v[4], v[5]); o.w = pk2(v[6], v[7]); *(uint4*)p = o; }
HD int mod_row(int r) { return r < TL ? r / S : NB; }
HD const float* mod_ptr(const P& p, int l, int r, int chunk) { return p.mod + ((size_t)(l * (NB + 1) + mod_row(r)) * 6 + chunk) * D; }
HD int win_src(int n) { return n < 2560 ? n : n < 7936 ? n + 32 : n < 7968 ? n - 7936 + 2560 : -1; }
HD int w1_src(int n) { const int j = n >> 8, i = n & 255; return i < 128 ? 128 * j + i : 1024 + 128 * j + (i - 128); }
#ifdef HOST_EMU
static inline int atomic_add_i(int* p, int v) { return __atomic_fetch_add(p, v, __ATOMIC_RELAXED); }
#else
__device__ __forceinline__ int atomic_add_i(int* p, int v) { return atomicAdd(p, v); }
#endif

struct FInit { P p; HD void operator()(long i) const {
    const long e = i * 4; const float4 v = e < (long)TL * D ? *(const float4*)(p.x + e) : *(const float4*)(p.ctx + (e - (long)TL * D)); *(float4*)(p.xl + e) = v; } };

struct FAda { P p; HD void operator()(long i) const {
    const int l = (int)(i / (6 * D)), col = (int)(i % (6 * D)); const float* w = p.w_ada + (size_t)l * D * 6 * D + col;
    float acc[9];
#pragma unroll
    for (int r = 0; r < 9; ++r) acc[r] = 0.f;
    for (int k = 0; k < D; ++k) { const float wv = w[(size_t)k * 6 * D];
#pragma unroll
        for (int r = 0; r < 9; ++r) { if (r <= NB) { const float cv = r < NB ? p.c[r * D + k] : p.c_ctx[k]; acc[r] += siluf_(cv) * wv; } } }
#pragma unroll
    for (int r = 0; r < 9; ++r) if (r <= NB) p.mod[((size_t)(l * (NB + 1) + r)) * 6 * D + col] = acc[r] + p.b_ada[(size_t)l * 6 * D + col]; } };

HD void moe_combine_row(const P& p, int lp, int r) {
    const float* g2 = mod_ptr(p, lp, r, 5); float* xr = p.xl + (size_t)r * D;
    const int s0 = p.slot_of[r * 4 + 0], s1 = p.slot_of[r * 4 + 1], s2 = p.slot_of[r * 4 + 2], s3 = p.slot_of[r * 4 + 3];
    const float w0 = p.topw[r * 4 + 0], w1 = p.topw[r * 4 + 1], w2 = p.topw[r * 4 + 2], w3 = p.topw[r * 4 + 3];
    for (int k = 0; k < D; k += 8) { float a[8], b[8], c[8], d[8];
        ld8(p.ys + (size_t)s0 * D + k, a); ld8(p.ys + (size_t)s1 * D + k, b); ld8(p.ys + (size_t)s2 * D + k, c); ld8(p.ys + (size_t)s3 * D + k, d);
        for (int j = 0; j < 8; ++j) xr[k + j] += g2[k + j] * (((w0 * a[j] + w1 * b[j]) + w2 * c[j]) + w3 * d[j]); } }

struct FNorm1 { P p; int l, combine; HD void operator()(long i) const {
    const int r = (int)i; if (r < NE) { p.cnt[r] = 0; p.cursor[r] = 0; }
    if (combine) moe_combine_row(p, l - 1, r);
    const float* xr = p.xl + (size_t)r * D; float ss = 0.f;
    for (int k = 0; k < D; ++k) ss += xr[k] * xr[k];
    const float rstd = 1.f / sqrtf(ss * (1.f / D) + NORM_EPS);
    const float* sh = mod_ptr(p, l, r, 0); const float* sc = mod_ptr(p, l, r, 1); const float* g = p.norm1_g + (size_t)l * D;
    for (int k = 0; k < D; k += 8) { float v[8];
        for (int j = 0; j < 8; ++j) v[j] = xr[k + j] * rstd * g[k + j] * (1.f + sc[k + j]) + sh[k + j];
        st8(p.h + (size_t)r * D + k, v); } } };

struct FConv { P p; int l, pad; HD void operator()(long i) const {
    const int r = (int)(i / 1536), ch = (int)(i % 1536); int lo, hi;
    if (r < TL) { lo = (r / S) * S; hi = lo + S; } else { lo = TL + ((r - TL) / LC) * LC; hi = lo + LC; }
    float acc = p.conv_b[l * 1536 + ch];
    for (int j = 0; j < 5; ++j) { const int rr = r + j - 2; if (rr >= lo && rr < hi) acc += p.conv_w[(l * 5 + j) * 1536 + ch] * bf2f(p.proj[(size_t)rr * NPROJ + PC_XBC + ch]); }
    p.xa[(size_t)r * 1536 + ch] = f2bf(siluf_(acc)); } };

struct FRope { P p; HD void operator()(long i) const {
    const int i16 = (int)(i & 15), hf = (int)((i >> 4) & 1); const long q = i >> 5; const int j = (int)(q % 10), r = (int)(q / 10);
    const int s = r % S, pos = hf == 0 ? s / GW : s % GW;
    const float inv = expf(-(float)(2 * i16) * (1.f / 32.f) * 9.210340371976184f), ang = (float)pos * inv, cs = cosf(ang), sn = sinf(ang);
    const bf16* src; bf16* dst;
    if (j < 8) { src = p.proj + (size_t)r * NPROJ + PC_QS + j * 64 + hf * 32; dst = p.qsr + (size_t)r * 512 + j * 64 + hf * 32; }
    else { src = p.proj + (size_t)r * NPROJ + PC_KS + (j - 8) * 64 + hf * 32; dst = p.ksr + (size_t)r * 128 + (j - 8) * 64 + hf * 32; }
    const float u1 = bf2f(src[i16]), u2 = bf2f(src[i16 + 16]);
    dst[i16] = f2bf(u1 * cs - u2 * sn); dst[i16 + 16] = f2bf(u2 * cs + u1 * sn); } };

struct FScan { P p; int l, pad; HD void operator()(long i) const {
    const int pp = (int)(i & 63), dir = (int)((i >> 6) & 1), hh = (int)((i >> 7) & 15), b = (int)(i >> 11);
    const float A = -expf(p.a_log[(l * 2 + dir) * 16 + hh]), bias = p.dt_bias[(l * 2 + dir) * 16 + hh]; const int g = hh >> 3;
    float st[128];
#pragma unroll
    for (int n = 0; n < 128; ++n) st[n] = 0.f;
    float* yo = dir ? p.yb : p.yf;
    for (int step = 0; step < LC + S; ++step) {
        int r;
        if (dir == 0) r = step < LC ? TL + b * LC + step : b * S + (step - LC);
        else r = step < LC ? TL + b * LC + (LC - 1 - step) : b * S + (S - 1 - (step - LC));
        const float dtv = softplusf_(p.dt[(size_t)r * 32 + dir * 16 + hh] + bias), a = expf(dtv * A), xv = bf2f(p.xa[(size_t)r * 1536 + hh * 64 + pp]) * dtv;
        const bf16* Bp = p.xa + (size_t)r * 1536 + 1024 + g * 128; const bf16* Cp = Bp + 256; float y = 0.f;
#pragma unroll
        for (int n = 0; n < 128; n += 8) { float bv[8], cv[8]; ld8(Bp + n, bv); ld8(Cp + n, cv);
#pragma unroll
            for (int j = 0; j < 8; ++j) { st[n + j] = a * st[n + j] + xv * bv[j]; y += st[n + j] * cv[j]; } }
        yo[(size_t)r * 1024 + hh * 64 + pp] = y; } } };

struct FSsdOut { P p; int l, pad; HD void operator()(long i) const {
    const int r = (int)i; float ss = 0.f;
    for (int ch = 0; ch < 1024; ++ch) { const float y = (p.yf[(size_t)r * 1024 + ch] + p.yb[(size_t)r * 1024 + ch] + p.ssd_d[l * 16 + (ch >> 6)] * bf2f(p.xa[(size_t)r * 1536 + ch])) * siluf_(bf2f(p.proj[(size_t)r * NPROJ + PC_Z + ch])); ss += y * y; }
    const float rstd = 1.f / sqrtf(ss * (1.f / 1024.f) + NORM_EPS);
    for (int ch = 0; ch < 1024; ++ch) { const float y = (p.yf[(size_t)r * 1024 + ch] + p.yb[(size_t)r * 1024 + ch] + p.ssd_d[l * 16 + (ch >> 6)] * bf2f(p.xa[(size_t)r * 1536 + ch])) * siluf_(bf2f(p.proj[(size_t)r * NPROJ + PC_Z + ch]));
        p.ossd[(size_t)r * 1024 + ch] = f2bf(y * rstd * p.ssd_norm_g[l * 1024 + ch]); } } };

#define ATT_KEY(kptr, vptr, extra) do { float sc_ = 0.f; \
    _Pragma("unroll") for (int d_ = 0; d_ < 64; d_ += 8) { float kv_[8]; ld8((kptr) + d_, kv_); _Pragma("unroll") for (int j_ = 0; j_ < 8; ++j_) sc_ += q[d_ + j_] * kv_[j_]; } \
    sc_ = sc_ * 0.125f + (extra); const float mn_ = sc_ > mx ? sc_ : mx; const float cf_ = expf(mx - mn_), pe_ = expf(sc_ - mn_); den = den * cf_ + pe_; mx = mn_; \
    _Pragma("unroll") for (int d_ = 0; d_ < 64; d_ += 8) { float vv_[8]; ld8((vptr) + d_, vv_); _Pragma("unroll") for (int j_ = 0; j_ < 8; ++j_) o[d_ + j_] = o[d_ + j_] * cf_ + pe_ * vv_[j_]; } } while (0)

struct FSwa { P p; int l, pad; HD void operator()(long i) const {
    const int hq = (int)(i & 7), r = (int)(i >> 3), kvh = hq >> 2; const float sink = p.swa_sink[l * 8 + hq];
    float q[64], o[64]; float mx = sink, den = 1.f;
#pragma unroll
    for (int d = 0; d < 64; ++d) o[d] = 0.f;
    int b;
    if (r < TL) { b = r / S; const int s = r % S;
#pragma unroll
        for (int d = 0; d < 64; d += 8) ld8(p.qsr + (size_t)r * 512 + hq * 64 + d, q + d);
        const int j0 = s - 128 < 0 ? 0 : s - 128, j1 = s + 128 > S - 1 ? S - 1 : s + 128;
        for (int j = j0; j <= j1; ++j) { const size_t rr = (size_t)b * S + j; ATT_KEY(p.ksr + rr * 128 + kvh * 64, p.proj + rr * NPROJ + PC_VS + kvh * 64, 0.f); }
    } else { b = (r - TL) / LC;
#pragma unroll
        for (int d = 0; d < 64; d += 8) ld8(p.proj + (size_t)r * NPROJ + PC_QS + hq * 64 + d, q + d); }
    for (int cj = 0; cj < LC; ++cj) { const size_t rr = (size_t)TL + (size_t)b * LC + cj; ATT_KEY(p.proj + rr * NPROJ + PC_KS + kvh * 64, p.proj + rr * NPROJ + PC_VS + kvh * 64, 0.f); }
    const float inv = 1.f / den;
#pragma unroll
    for (int d = 0; d < 64; d += 8) { float v[8];
#pragma unroll
        for (int j = 0; j < 8; ++j) v[j] = o[d + j] * inv;
        st8(p.oswa + (size_t)r * 512 + hq * 64 + d, v); } } };

struct FNa { P p; int l, pad; HD void operator()(long i) const {
    const int hh = (int)(i & 7), r = (int)(i >> 3);
    float q[64], o[64]; float mx = -1e30f, den = 0.f;
#pragma unroll
    for (int d = 0; d < 64; ++d) o[d] = 0.f;
#pragma unroll
    for (int d = 0; d < 64; d += 8) ld8(p.proj + (size_t)r * NPROJ + PC_QN + hh * 64 + d, q + d);
    int b;
    if (r < TL) { b = r / S; const int s = r % S, qr = s / GW, qc = s % GW;
        int r0 = qr - 4; r0 = r0 < 0 ? 0 : (r0 > 24 ? 24 : r0); int c0 = qc - 8; c0 = c0 < 0 ? 0 : (c0 > 48 ? 48 : c0);
        const float* rpb = p.na_rpb + (size_t)(l * 8 + hh) * 15 * 31;
        for (int kr = r0; kr < r0 + 8; ++kr) for (int kc = c0; kc < c0 + 16; ++kc) { const size_t rr = (size_t)b * S + kr * GW + kc;
            const float bias = rpb[(kr - qr + 7) * 31 + (kc - qc + 15)];
            ATT_KEY(p.proj + rr * NPROJ + PC_KN + hh * 64, p.proj + rr * NPROJ + PC_VN + hh * 64, bias); }
    } else b = (r - TL) / LC;
    for (int cj = 0; cj < LC; ++cj) { const size_t rr = (size_t)TL + (size_t)b * LC + cj; ATT_KEY(p.proj + rr * NPROJ + PC_KN + hh * 64, p.proj + rr * NPROJ + PC_VN + hh * 64, 0.f); }
    const float inv = 1.f / den;
#pragma unroll
    for (int d = 0; d < 64; d += 8) { float v[8];
#pragma unroll
        for (int j = 0; j < 8; ++j) v[j] = o[d + j] * inv;
        st8(p.ona + (size_t)r * 512 + hh * 64 + d, v); } } };

struct FNorm2 { P p; int l, pad; HD void operator()(long i) const {
    const int r = (int)i; const float* xr = p.xl + (size_t)r * D; float ss = 0.f;
    for (int k = 0; k < D; ++k) ss += xr[k] * xr[k];
    const float rstd = 1.f / sqrtf(ss * (1.f / D) + NORM_EPS);
    const float* sh = mod_ptr(p, l, r, 3); const float* sc = mod_ptr(p, l, r, 4); const float* g = p.norm2_g + (size_t)l * D; const float* rw = p.router_w + (size_t)l * D * NE;
    float lg[NE];
#pragma unroll
    for (int e = 0; e < NE; ++e) lg[e] = p.router_b[l * NE + e];
    for (int k = 0; k < D; k += 8) { float v[8];
        for (int j = 0; j < 8; ++j) { v[j] = xr[k + j] * rstd * g[k + j] * (1.f + sc[k + j]) + sh[k + j]; const float* w = rw + (size_t)(k + j) * NE;
#pragma unroll
            for (int e = 0; e < NE; ++e) lg[e] += v[j] * w[e]; }
        st8(p.h + (size_t)r * D + k, v); }
    float tv[4]; int ti[4];
#pragma unroll
    for (int j = 0; j < 4; ++j) { float best = -3e38f; int bi = 0;
#pragma unroll
        for (int e = 0; e < NE; ++e) if (lg[e] > best) { best = lg[e]; bi = e; }
#pragma unroll
        for (int e = 0; e < NE; ++e) if (e == bi) lg[e] = -3e38f;
        tv[j] = best; ti[j] = bi; }
    const float e1 = expf(tv[1] - tv[0]), e2 = expf(tv[2] - tv[0]), e3 = expf(tv[3] - tv[0]), inv = 1.f / (1.f + e1 + e2 + e3);
    p.topw[r * 4 + 0] = inv; p.topw[r * 4 + 1] = e1 * inv; p.topw[r * 4 + 2] = e2 * inv; p.topw[r * 4 + 3] = e3 * inv;
#pragma unroll
    for (int j = 0; j < 4; ++j) { p.topi[r * 4 + j] = ti[j]; atomic_add_i(p.cnt + ti[j], 1); } } };

struct FPlan { P p; HD void operator()(long) const {
    int tot = 0, n1 = 0, n2 = 0;
    for (int e = 0; e < NE; ++e) { const int c = p.cnt[e], nt = (c + 255) >> 8; p.pstart[e] = tot;
        for (int rt = 0; rt < nt; ++rt) { const int pm = (tot >> 8) + rt;
            for (int j = 0; j < 8; ++j) p.units1[n1++] = (pm << 16) | (e * 8 + j);
            for (int j = 0; j < 4; ++j) p.units2[n2++] = (pm << 16) | (e * 4 + j); }
        tot += nt << 8; }
    p.pstart[NE] = tot; p.nunits[0] = n1; p.nunits[1] = n2; } };
struct FSlotInit { P p; HD void operator()(long i) const { p.slot_tok[i] = -1; } };
struct FAssign { P p; HD void operator()(long i) const {
    const int e = p.topi[i], pos = atomic_add_i(p.cursor + e, 1), slot = p.pstart[e] + pos; p.slot_of[i] = slot; p.slot_tok[slot] = (int)(i >> 2); } };
struct FGather { P p; HD void operator()(long i) const {
    const int slot = (int)(i >> 7), c8 = (int)(i & 127) * 8; if (slot >= p.pstart[NE]) return; const int t = p.slot_tok[slot];
    uint4 v; v.x = v.y = v.z = v.w = 0u; if (t >= 0) v = *(const uint4*)(p.h + (size_t)t * D + c8); *(uint4*)(p.xs + (size_t)slot * D + c8) = v; } };

struct FFinal { P p; HD void operator()(long i) const {
    const int r = (int)i; moe_combine_row(p, NL - 1, r);
    const float* xr = p.xl + (size_t)r * D; float ss = 0.f;
    for (int k = 0; k < D; ++k) ss += xr[k] * xr[k];
    const float rstd = 1.f / sqrtf(ss * (1.f / D) + NORM_EPS);
    for (int k = 0; k < D; ++k) p.out[(size_t)r * D + k] = xr[k] * rstd * p.final_g[k]; } };

HD float swiglu_(float g, float u) { g = g < 7.f ? g : 7.f; u = u < -7.f ? -7.f : (u > 7.f ? 7.f : u); return (u + 1.f) * g * sigmoidf_(1.702f * g); }

template <class Ex> static void forward(Ex& ex, const P& p) {
    ex.prep_weights();
    ex.items((long)TT * D / 4, FInit{p});
    ex.items((long)NL * 6 * D, FAda{p});
    for (int l = 0; l < NL; ++l) {
        const bool last = (l == NL - 1); const int rows = last ? TL : TT;
        ex.items(TT, FNorm1{p, l, l > 0 ? 1 : 0});
        ex.gemm_win(l);
        ex.items((long)TT * 1536, FConv{p, l, 0});
        ex.items((long)TL * 10 * 32, FRope{p});
        ex.items((long)NB * 16 * 2 * 64, FScan{p, l, 0});
        ex.items(rows, FSsdOut{p, l, 0});
        ex.items((long)rows * 8, FSwa{p, l, 0});
        ex.items((long)rows * 8, FNa{p, l, 0});
        ex.gemm_merge(l, rows);
        ex.gemm_wout(l, rows);
        ex.items(rows, FNorm2{p, l, 0});
        ex.items(1, FPlan{p});
        ex.items(NSLOT, FSlotInit{p});
        ex.items((long)rows * 4, FAssign{p});
        ex.items((long)NSLOT * 128, FGather{p});
        ex.gemm_moe1(l);
        ex.gemm_moe2(l);
    }
    ex.items(TL, FFinal{p});
}

#ifndef HOST_EMU
namespace pg8 {
#define PG8_LAS __attribute__((address_space(3)))
typedef unsigned short bf16_t;
typedef short bf16x8 __attribute__((ext_vector_type(8)));
typedef float f32x4 __attribute__((ext_vector_type(4)));
typedef unsigned u32x4 __attribute__((ext_vector_type(4)));
constexpr int BM = 256, BK = 64, HALF = 128, HTB = HALF * BK * 2, STAGE_BYTES = 8 * HTB, NXCD = 8, WGM = 8;
__host__ __device__ __forceinline__ int lds_byte(int r, int c) { const int st = (r >> 4) * 2 + (c >> 5), rr = r & 15, cc = c & 31, ob = rr * 64 + cc * 2; return st * 1024 + (ob ^ (((ob >> 9) & 1) << 5)); }
__host__ __device__ __forceinline__ void stage_rc(int b, int& R, int& C) { const int st = b / 1024, sb = b % 1024, swz = sb ^ (((sb >> 9) & 1) << 5); R = (st >> 1) * 16 + swz / 64; C = (st & 1) * 32 + (swz % 64) / 2; }
__host__ __device__ __forceinline__ int perm32(int rho) { const int n = rho >> 4, i = rho & 15; return 8 * (i >> 2) + 4 * n + (i & 3); }
struct Unit { int pm, pn; };
struct Gemm { const bf16_t* A; const bf16_t* Bt; int M, N, K, pad; };
struct StaticOrder {
    int nM, nN, nwg, G, c;
    __host__ __device__ void init(int M, int N, int G_, int c_) { nM = M / BM; nN = N / BM; nwg = nM * nN; G = G_; c = c_; }
    __host__ __device__ bool next(int i, Unit& u) const {
        const long L = (long)i * G + c; if (L >= nwg) return false;
        int wgid = (int)L; { const int q = nwg / NXCD, r = nwg % NXCD, xcd = wgid % NXCD, off = wgid / NXCD; wgid = (xcd < r ? xcd * (q + 1) : r * (q + 1) + (xcd - r) * q) + off; }
        const int nig = WGM * nN, gid = wgid / nig, fm = gid * WGM, gsz = (nM - fm) < WGM ? (nM - fm) : WGM;
        u.pm = fm + ((wgid % nig) % gsz); u.pn = (wgid % nig) / gsz; return true;
    }
    __device__ __forceinline__ void a_ready(const Unit&) const {}
    __device__ __forceinline__ void done(const Unit&) const {}
};
struct TableOrder {
    const int* tab; int n, G, c;
    __device__ bool next(int i, Unit& u) const { const long L = (long)i * G + c; if (L >= n) return false; const int v = tab[L]; u.pm = v >> 16; u.pn = v & 0xffff; return true; }
    __device__ __forceinline__ void a_ready(const Unit&) const {}
    __device__ __forceinline__ void done(const Unit&) const {}
};
__device__ __forceinline__ unsigned cvt_pk_bf16(float lo, float hi) { unsigned r; asm volatile("v_cvt_pk_bf16_f32 %0, %1, %2" : "=v"(r) : "v"(lo), "v"(hi)); return r; }

template <class Epi, class Sched, bool ALIGN_EPI = false, bool SP2 = false>
__device__ __forceinline__ void gemm_phase(PG8_LAS unsigned char* lds, const Gemm g, const Sched& S, const Epi& E) {
    const int tid = threadIdx.x, wid = __builtin_amdgcn_readfirstlane(tid >> 6), lane = tid & 63, wr = wid >> 2, wc = wid & 3, fr = lane & 15, fq = lane >> 4;
    const int K = g.K, nt = K / BK;
    unsigned voffA[2], voffB[2];
#pragma unroll
    for (int i = 0; i < 2; ++i) { int R, C; stage_rc(tid * 16 + i * 8192, R, C); const int Rb = Epi::PERM ? ((R & ~31) + perm32(R & 31)) : R;
        voffA[i] = (unsigned)(R * K + C) * 2u; voffB[i] = (unsigned)(Rb * K + C) * 2u; }
    const size_t kstep = (size_t)(BK * 2);
    const size_t hstep = (size_t)HALF * K * 2;
    const size_t tstep = 2 * hstep;
    const unsigned ldsw = (unsigned)wid * 1024u;
    const int aoff = lds_byte(wr * 64 + fr, fq * 8), boff = lds_byte(wc * 32 + fr, fq * 8);
#define PG8_SA(b, h) (((b) * 2 + (h)) * HTB)
#define PG8_SB(b, h) ((4 + (b) * 2 + (h)) * HTB)
#define PG8_STAGE(bufoff, gbase, voff) do { _Pragma("unroll") for (int _i = 0; _i < 2; ++_i) \
        __builtin_amdgcn_global_load_lds((const unsigned*)((const char*)(gbase) + (voff)[_i]), (PG8_LAS unsigned*)(lds + (bufoff) + ldsw + _i * 8192), 16, 0, 0); } while (0)
#define PG8_LDA(dst, b, h) do { _Pragma("unroll") for (int m = 0; m < 4; ++m) _Pragma("unroll") for (int k = 0; k < 2; ++k) dst[m][k] = *(const PG8_LAS bf16x8*)(lds + PG8_SA(b, h) + aoff + m * 2048 + k * 1024); } while (0)
#define PG8_LDB(dst, b, h) do { _Pragma("unroll") for (int n = 0; n < 2; ++n) _Pragma("unroll") for (int k = 0; k < 2; ++k) dst[n][k] = *(const PG8_LAS bf16x8*)(lds + PG8_SB(b, h) + boff + n * 2048 + k * 1024); } while (0)
#define PG8_MMA(ai, bj, At, Bt) do { __builtin_amdgcn_s_setprio(1); _Pragma("unroll") for (int m = 0; m < 4; ++m) _Pragma("unroll") for (int n = 0; n < 2; ++n) _Pragma("unroll") for (int k = 0; k < 2; ++k) \
        acc[ai][bj][m][n] = __builtin_amdgcn_mfma_f32_16x16x32_bf16(Bt[n][k], At[m][k], acc[ai][bj][m][n], 0, 0, 0); __builtin_amdgcn_s_setprio(0); } while (0)
#define PG8_WAIT_V(n) asm volatile("s_waitcnt vmcnt(" #n ")" ::: "memory")
#define PG8_WAIT_L(n) asm volatile("s_waitcnt lgkmcnt(" #n ")" ::: "memory")
#define PG8_BAR __builtin_amdgcn_s_barrier()
#define PG8_SCHED __builtin_amdgcn_sched_barrier(0)
    Unit cur, nxt; int ui = 0;
    if (!S.next(0, cur)) return;
    f32x4 acc[2][2][4][2];
#pragma unroll
    for (int a = 0; a < 2; ++a)
#pragma unroll
        for (int b = 0; b < 2; ++b)
#pragma unroll
            for (int m = 0; m < 4; ++m)
#pragma unroll
                for (int n = 0; n < 2; ++n) acc[a][b][m][n] = (f32x4){0.f, 0.f, 0.f, 0.f};
    bf16x8 At[4][2], B0[2][2], B1[2][2];
    const char* cA = (const char*)g.A + (size_t)cur.pm * tstep; const char* cB = (const char*)g.Bt + (size_t)cur.pn * tstep;
    S.a_ready(cur);
    if constexpr (SP2) {
        PG8_STAGE(PG8_SB(0, 0), cB, voffB); PG8_STAGE(PG8_SB(0, 1), cB + hstep, voffB); PG8_STAGE(PG8_SA(0, 0), cA, voffA); PG8_STAGE(PG8_SA(0, 1), cA + hstep, voffA);
        if (wr == 1) PG8_BAR;
        PG8_WAIT_V(2); PG8_BAR;
        PG8_STAGE(PG8_SB(1, 0), cB + kstep, voffB); PG8_STAGE(PG8_SA(1, 0), cA + kstep, voffA); PG8_STAGE(PG8_SB(1, 1), cB + hstep + kstep, voffB);
        PG8_WAIT_V(6); PG8_BAR;
    } else {
        PG8_STAGE(PG8_SB(0, 0), cB, voffB); PG8_STAGE(PG8_SA(0, 0), cA, voffA); PG8_STAGE(PG8_SB(0, 1), cB + hstep, voffB); PG8_STAGE(PG8_SA(0, 1), cA + hstep, voffA);
        if (wr == 1) PG8_BAR;
        PG8_WAIT_V(4); PG8_BAR;
        PG8_STAGE(PG8_SB(1, 0), cB + kstep, voffB); PG8_STAGE(PG8_SA(1, 0), cA + kstep, voffA); PG8_STAGE(PG8_SB(1, 1), cB + hstep + kstep, voffB);
        PG8_WAIT_V(6); PG8_BAR;
    }
    for (;;) {
        const bool has_next = S.next(ui + 1, nxt);
        const char* nA = has_next ? (const char*)g.A + (size_t)nxt.pm * tstep : cA; const char* nB = has_next ? (const char*)g.Bt + (size_t)nxt.pn * tstep : cB;
        for (int t = 0; t < nt; t += 2) {
            const bool last = (t == nt - 2);
            const char* a1 = cA + (size_t)(t + 1) * kstep;
            const char* a2 = last ? nA : cA + (size_t)(t + 2) * kstep; const char* b2 = last ? nB : cB + (size_t)(t + 2) * kstep;
            const char* a3 = a2 + kstep; const char* b3 = b2 + kstep;
            if (last && has_next) S.a_ready(nxt);
            if constexpr (SP2) {
            PG8_LDB(B0, 0, 0); PG8_LDB(B1, 0, 1); PG8_SCHED; PG8_LDA(At, 0, 0); PG8_STAGE(PG8_SA(1, 1), a1 + hstep, voffA);
            PG8_WAIT_V(8); PG8_WAIT_L(0); PG8_BAR; PG8_MMA(0, 0, At, B0); PG8_MMA(0, 1, At, B1); PG8_BAR; PG8_SCHED;
            PG8_LDA(At, 0, 1); PG8_STAGE(PG8_SB(0, 0), b2, voffB); PG8_STAGE(PG8_SB(0, 1), b2 + hstep, voffB); PG8_STAGE(PG8_SA(0, 0), a2, voffA);
            PG8_WAIT_V(8); PG8_WAIT_L(0); PG8_BAR; PG8_MMA(1, 0, At, B0); PG8_MMA(1, 1, At, B1); PG8_BAR; PG8_SCHED;
            PG8_LDB(B0, 1, 0); PG8_LDB(B1, 1, 1); PG8_SCHED; PG8_LDA(At, 1, 0); PG8_STAGE(PG8_SA(0, 1), a2 + hstep, voffA);
            PG8_WAIT_V(8); PG8_WAIT_L(0); PG8_BAR; PG8_MMA(0, 0, At, B0); PG8_MMA(0, 1, At, B1); PG8_BAR; PG8_SCHED;
            PG8_LDA(At, 1, 1); PG8_STAGE(PG8_SB(1, 0), b3, voffB); PG8_STAGE(PG8_SB(1, 1), b3 + hstep, voffB); PG8_STAGE(PG8_SA(1, 0), a3, voffA);
            PG8_WAIT_V(8); PG8_WAIT_L(0); PG8_BAR; PG8_MMA(1, 0, At, B0); PG8_MMA(1, 1, At, B1); PG8_BAR; PG8_SCHED;
            } else {
            PG8_LDB(B0, 0, 0); PG8_SCHED; PG8_LDA(At, 0, 0); PG8_STAGE(PG8_SA(1, 1), a1 + hstep, voffA);
            PG8_WAIT_L(8); PG8_BAR; PG8_WAIT_L(0); PG8_MMA(0, 0, At, B0); PG8_BAR; PG8_SCHED;
            PG8_LDB(B1, 0, 1); PG8_STAGE(PG8_SB(0, 0), b2, voffB);
            PG8_BAR; PG8_WAIT_L(0); PG8_MMA(0, 1, At, B1); PG8_BAR;
            PG8_LDA(At, 0, 1); PG8_STAGE(PG8_SA(0, 0), a2, voffA);
            PG8_BAR; PG8_WAIT_L(0); PG8_MMA(1, 0, At, B0); PG8_BAR; PG8_SCHED;
            PG8_STAGE(PG8_SB(0, 1), b2 + hstep, voffB);
            PG8_WAIT_V(6); PG8_BAR; PG8_MMA(1, 1, At, B1); PG8_BAR;
            PG8_LDB(B0, 1, 0); PG8_SCHED; PG8_LDA(At, 1, 0); PG8_STAGE(PG8_SA(0, 1), a2 + hstep, voffA);
            PG8_WAIT_L(8); PG8_BAR; PG8_WAIT_L(0); PG8_MMA(0, 0, At, B0); PG8_BAR; PG8_SCHED;
            PG8_LDB(B1, 1, 1); PG8_STAGE(PG8_SB(1, 0), b3, voffB);
            PG8_BAR; PG8_WAIT_L(0); PG8_MMA(0, 1, At, B1); PG8_BAR;
            PG8_LDA(At, 1, 1); PG8_STAGE(PG8_SA(1, 0), a3, voffA);
            PG8_BAR; PG8_WAIT_L(0); PG8_MMA(1, 0, At, B0); PG8_BAR; PG8_SCHED;
            PG8_STAGE(PG8_SB(1, 1), b3 + hstep, voffB);
            PG8_WAIT_V(6); PG8_BAR; PG8_MMA(1, 1, At, B1); PG8_BAR;
            }
        }
        if constexpr (ALIGN_EPI) { if (wr == 0) PG8_BAR; }
        E(acc, cur, wr, wc, fr, fq); S.done(cur);
        if (!has_next) break;
#pragma unroll
        for (int a = 0; a < 2; ++a)
#pragma unroll
            for (int b = 0; b < 2; ++b)
#pragma unroll
                for (int m = 0; m < 4; ++m)
#pragma unroll
                    for (int n = 0; n < 2; ++n) acc[a][b][m][n] = (f32x4){0.f, 0.f, 0.f, 0.f};
        cur = nxt; cA = nA; cB = nB; ++ui;
        if constexpr (ALIGN_EPI) { if (wr == 1) PG8_BAR; }
    }
    PG8_WAIT_V(0);
    if constexpr (!ALIGN_EPI) { if (wr == 0) PG8_BAR; }
    PG8_BAR;
#undef PG8_SA
#undef PG8_SB
#undef PG8_STAGE
#undef PG8_LDA
#undef PG8_LDB
#undef PG8_MMA
#undef PG8_WAIT_V
#undef PG8_WAIT_L
#undef PG8_BAR
#undef PG8_SCHED
}

typedef const f32x4 (&AccRef)[2][2][4][2];
__device__ __forceinline__ u32x4 pack8(const f32x4 a, const f32x4 b) { u32x4 w; w.x = cvt_pk_bf16(a[0], a[1]); w.y = cvt_pk_bf16(a[2], a[3]); w.z = cvt_pk_bf16(b[0], b[1]); w.w = cvt_pk_bf16(b[2], b[3]); return w; }
__device__ __forceinline__ void unpack8(const u32x4 w, f32x4& a, f32x4& b) {
    a[0] = __uint_as_float(w.x << 16); a[1] = __uint_as_float(w.x & 0xffff0000u); a[2] = __uint_as_float(w.y << 16); a[3] = __uint_as_float(w.y & 0xffff0000u);
    b[0] = __uint_as_float(w.z << 16); b[1] = __uint_as_float(w.z & 0xffff0000u); b[2] = __uint_as_float(w.w << 16); b[3] = __uint_as_float(w.w & 0xffff0000u); }
__device__ __forceinline__ f32x4 sig4(const f32x4 x) { f32x4 r; for (int j = 0; j < 4; ++j) r[j] = 1.f / (1.f + __expf(-x[j])); return r; }

struct EpiWin {
    static constexpr bool PERM = true, AFTER_DRAIN = false;
    bf16_t* proj; float* dt;
    __device__ __forceinline__ void operator()(AccRef acc, const Unit& u, int wr, int wc, int fr, int fq) const {
        const int row0 = u.pm * BM + wr * 64 + fr;
        if (u.pn < 31) { const int col0 = u.pn * BM + wc * 32 + 8 * fq;
#pragma unroll
            for (int ai = 0; ai < 2; ++ai)
#pragma unroll
                for (int m = 0; m < 4; ++m) { bf16_t* rowp = proj + (size_t)(row0 + ai * HALF + m * 16) * NPROJ + col0;
#pragma unroll
                    for (int bj = 0; bj < 2; ++bj) *(u32x4*)(rowp + bj * HALF) = pack8(acc[ai][bj][m][0], acc[ai][bj][m][1]); }
        } else if (wc == 0) {
#pragma unroll
            for (int ai = 0; ai < 2; ++ai)
#pragma unroll
                for (int m = 0; m < 4; ++m) { float* rowp = dt + (size_t)(row0 + ai * HALF + m * 16) * 32 + 8 * fq;
                    *(f32x4*)rowp = acc[ai][0][m][0]; *(f32x4*)(rowp + 4) = acc[ai][0][m][1]; }
        }
    }
};
template <int PASS> struct EpiMerge {
    static constexpr bool PERM = true, AFTER_DRAIN = false;
    const bf16_t* gsrc; const float* bg; float* macc; bf16_t* mo;
    __device__ __forceinline__ void operator()(AccRef acc, const Unit& u, int wr, int wc, int fr, int fq) const {
        const int row0 = u.pm * BM + wr * 64 + fr, col0 = u.pn * BM + wc * 32 + 8 * fq;
#pragma unroll
        for (int bj = 0; bj < 2; ++bj) { const int col = col0 + bj * HALF; const f32x4 b0 = *(const f32x4*)(bg + col), b1 = *(const f32x4*)(bg + col + 4);
#pragma unroll
            for (int ai = 0; ai < 2; ++ai)
#pragma unroll
                for (int m = 0; m < 4; ++m) { const size_t row = (size_t)(row0 + ai * HALF + m * 16);
                    f32x4 g0, g1; unpack8(*(const u32x4*)(gsrc + row * NPROJ + col), g0, g1);
                    f32x4 v0 = sig4(g0 + b0) * acc[ai][bj][m][0], v1 = sig4(g1 + b1) * acc[ai][bj][m][1];
                    float* mp = macc + row * D + col;
                    if (PASS == 0) { *(f32x4*)mp = v0; *(f32x4*)(mp + 4) = v1; }
                    else if (PASS == 1) { *(f32x4*)mp = *(const f32x4*)mp + v0; *(f32x4*)(mp + 4) = *(const f32x4*)(mp + 4) + v1; }
                    else { v0 = v0 + *(const f32x4*)mp; v1 = v1 + *(const f32x4*)(mp + 4); *(u32x4*)(mo + row * D + col) = pack8(v0, v1); } } }
    }
};
struct EpiWout {
    static constexpr bool PERM = true, AFTER_DRAIN = false;
    float* xl; const float* modl;
    __device__ __forceinline__ void operator()(AccRef acc, const Unit& u, int wr, int wc, int fr, int fq) const {
        const int row0 = u.pm * BM + wr * 64 + fr, col0 = u.pn * BM + wc * 32 + 8 * fq;
        const int mr = u.pm < TL / BM ? u.pm / (S / BM) : NB; const float* g1 = modl + ((size_t)mr * 6 + 2) * D;
#pragma unroll
        for (int bj = 0; bj < 2; ++bj) { const int col = col0 + bj * HALF; const f32x4 a0 = *(const f32x4*)(g1 + col), a1 = *(const f32x4*)(g1 + col + 4);
#pragma unroll
            for (int ai = 0; ai < 2; ++ai)
#pragma unroll
                for (int m = 0; m < 4; ++m) { float* xp = xl + (size_t)(row0 + ai * HALF + m * 16) * D + col;
                    *(f32x4*)xp = *(const f32x4*)xp + a0 * acc[ai][bj][m][0]; *(f32x4*)(xp + 4) = *(const f32x4*)(xp + 4) + a1 * acc[ai][bj][m][1]; } }
    }
};
struct EpiMoe1 {
    static constexpr bool PERM = true, AFTER_DRAIN = false;
    bf16_t* act; const float* b1;
    __device__ __forceinline__ void operator()(AccRef acc, const Unit& u, int wr, int wc, int fr, int fq) const {
        const int row0 = u.pm * BM + wr * 64 + fr, e = u.pn >> 3, j = u.pn & 7, col = j * 128 + wc * 32 + 8 * fq;
        const float* bp = b1 + (size_t)e * 2048 + col; const f32x4 bg0 = *(const f32x4*)bp, bg1 = *(const f32x4*)(bp + 4), bu0 = *(const f32x4*)(bp + 1024), bu1 = *(const f32x4*)(bp + 1028);
#pragma unroll
        for (int ai = 0; ai < 2; ++ai)
#pragma unroll
            for (int m = 0; m < 4; ++m) { const f32x4 g0 = acc[ai][0][m][0] + bg0, g1 = acc[ai][0][m][1] + bg1, u0 = acc[ai][1][m][0] + bu0, u1 = acc[ai][1][m][1] + bu1; f32x4 r0, r1;
#pragma unroll
                for (int q = 0; q < 4; ++q) { r0[q] = swiglu_(g0[q], u0[q]); r1[q] = swiglu_(g1[q], u1[q]); }
                *(u32x4*)(act + (size_t)(row0 + ai * HALF + m * 16) * D + col) = pack8(r0, r1); }
    }
};
struct EpiMoe2 {
    static constexpr bool PERM = true, AFTER_DRAIN = false;
    bf16_t* ys; const float* b2;
    __device__ __forceinline__ void operator()(AccRef acc, const Unit& u, int wr, int wc, int fr, int fq) const {
        const int row0 = u.pm * BM + wr * 64 + fr, e = u.pn >> 2, j = u.pn & 3, col0 = j * BM + wc * 32 + 8 * fq;
#pragma unroll
        for (int bj = 0; bj < 2; ++bj) { const int col = col0 + bj * HALF; const float* bp = b2 + (size_t)e * D + col; const f32x4 a0 = *(const f32x4*)bp, a1 = *(const f32x4*)(bp + 4);
#pragma unroll
            for (int ai = 0; ai < 2; ++ai)
#pragma unroll
                for (int m = 0; m < 4; ++m) *(u32x4*)(ys + (size_t)(row0 + ai * HALF + m * 16) * D + col) = pack8(acc[ai][bj][m][0] + a0, acc[ai][bj][m][1] + a1); }
    }
};
}

template <class F> __global__ void __launch_bounds__(256) k_items(long n, F f) {
    for (long i = (long)blockIdx.x * blockDim.x + threadIdx.x; i < n; i += (long)gridDim.x * blockDim.x) f(i);
}
template <class Epi> __global__ void __launch_bounds__(512, 2) k_gemm_static(pg8::Gemm g, Epi E) {
    extern __shared__ __attribute__((aligned(16))) unsigned char lds[];
    pg8::StaticOrder S; S.init(g.M, g.N, (int)gridDim.x, (int)blockIdx.x);
    pg8::gemm_phase<Epi, pg8::StaticOrder, true, true>((PG8_LAS unsigned char*)lds, g, S, E);
}
template <class Epi> __global__ void __launch_bounds__(512, 2) k_gemm_table(pg8::Gemm g, const int* tab, const int* n, Epi E) {
    extern __shared__ __attribute__((aligned(16))) unsigned char lds[];
    pg8::TableOrder S; S.tab = tab; S.n = *n; S.G = (int)gridDim.x; S.c = (int)blockIdx.x;
    pg8::gemm_phase<Epi, pg8::TableOrder, true, true>((PG8_LAS unsigned char*)lds, g, S, E);
}
struct TDesc { const float* src; bf16* dst; int K, Nsrc, Ndst, map; };
__device__ __forceinline__ void transpose_item(const TDesc& t, float* scr, int item, int lane) {
    const int nblk = t.Ndst / 32, kb = item / nblk, nb = item % nblk, k0 = 64 * kb, n0 = 32 * nb;
    const int s0 = t.map == 1 ? win_src(n0) : (t.map == 2 ? w1_src(n0) : n0);
#pragma unroll 8
    for (int i = 0; i < 32; ++i) { const int kk = 2 * i + (lane >> 5); scr[kk * 33 + (lane & 31)] = s0 >= 0 ? t.src[(size_t)(k0 + kk) * t.Nsrc + s0 + (lane & 31)] : 0.f; }
    __builtin_amdgcn_s_waitcnt(0xc07f); asm volatile("" ::: "memory");
    const int c = lane & 7;
#pragma unroll
    for (int j = 0; j < 4; ++j) { const int n = (lane >> 3) + 8 * j; const float* s = scr + (8 * c) * 33 + n;
        uint4 o; o.x = pk2(s[0 * 33], s[1 * 33]); o.y = pk2(s[2 * 33], s[3 * 33]); o.z = pk2(s[4 * 33], s[5 * 33]); o.w = pk2(s[6 * 33], s[7 * 33]);
        *(uint4*)(t.dst + (size_t)(n0 + n) * t.K + k0 + 8 * c) = o; }
    __builtin_amdgcn_s_waitcnt(0xc07f); asm volatile("" ::: "memory");
}
constexpr int TI_WIN = 16 * 256, TI_SQ = 16 * 32, TI_HALF = 8 * 32, TI_W1 = 16 * 64, TI_LAYER = TI_WIN + TI_SQ + 2 * TI_HALF + TI_SQ + NE * TI_W1 + NE * TI_SQ;
__global__ void __launch_bounds__(256) k_prep_weights(P p) {
    __shared__ float scr_all[4][64 * 33];
    const int lane = threadIdx.x & 63, w = threadIdx.x >> 6; float* scr = scr_all[w];
    const long gw = (long)blockIdx.x * 4 + w, ngw = (long)gridDim.x * 4;
    for (long it = gw; it < (long)NL * TI_LAYER; it += ngw) {
        const int l = (int)(it / TI_LAYER); int r = (int)(it % TI_LAYER); TDesc t;
        if (r < TI_WIN) t = TDesc{p.w_in + (size_t)l * D * 7968, p.w_in_t + (size_t)l * NPAD * D, D, 7968, NPAD, 1};
        else if ((r -= TI_WIN) < TI_SQ) t = TDesc{p.w_br_ssd + (size_t)l * 1024 * D, p.w_ssd_t + (size_t)l * D * 1024, 1024, D, D, 0};
        else if ((r -= TI_SQ) < TI_HALF) t = TDesc{p.w_br_swa + (size_t)l * 512 * D, p.w_swa_t + (size_t)l * D * 512, 512, D, D, 0};
        else if ((r -= TI_HALF) < TI_HALF) t = TDesc{p.w_br_na + (size_t)l * 512 * D, p.w_na_t + (size_t)l * D * 512, 512, D, D, 0};
        else if ((r -= TI_HALF) < TI_SQ) t = TDesc{p.w_out + (size_t)l * D * D, p.w_out_t + (size_t)l * D * D, D, D, D, 0};
        else if ((r -= TI_SQ) < NE * TI_W1) { const int e = r / TI_W1; r %= TI_W1; t = TDesc{p.moe_w1 + ((size_t)l * NE + e) * D * 2048, p.w1_t + ((size_t)l * NE + e) * 2048 * D, D, 2048, 2048, 2}; }
        else { r -= NE * TI_W1; const int e = r / TI_SQ; r %= TI_SQ; t = TDesc{p.moe_w2 + ((size_t)l * NE + e) * D * D, p.w2_t + ((size_t)l * NE + e) * D * D, D, D, D, 0}; }
        transpose_item(t, scr, r, lane);
    }
}

struct DevEx {
    P p; hipStream_t st;
    template <class F> void items(long n, F f) { long nb = (n + 255) / 256; if (nb > 16384) nb = 16384; if (nb < 1) nb = 1; hipLaunchKernelGGL((k_items<F>), dim3((unsigned)nb), dim3(256), 0, st, n, f); }
    template <class Epi> void gs(const bf16* A, const bf16* Bt, int M, int N, int K, Epi E) {
        static bool attr = false; if (!attr) { (void)hipFuncSetAttribute((const void*)k_gemm_static<Epi>, hipFuncAttributeMaxDynamicSharedMemorySize, pg8::STAGE_BYTES); attr = true; }
        pg8::Gemm g{A, Bt, M, N, K, 0}; hipLaunchKernelGGL((k_gemm_static<Epi>), dim3(256), dim3(512), pg8::STAGE_BYTES, st, g, E); }
    template <class Epi> void gt(const bf16* A, const bf16* Bt, int K, const int* tab, const int* n, Epi E) {
        static bool attr = false; if (!attr) { (void)hipFuncSetAttribute((const void*)k_gemm_table<Epi>, hipFuncAttributeMaxDynamicSharedMemorySize, pg8::STAGE_BYTES); attr = true; }
        pg8::Gemm g{A, Bt, 0, 0, K, 0}; hipLaunchKernelGGL((k_gemm_table<Epi>), dim3(256), dim3(512), pg8::STAGE_BYTES, st, g, tab, n, E); }
    void prep_weights() { hipLaunchKernelGGL(k_prep_weights, dim3(2048), dim3(256), 0, st, p); }
    void gemm_win(int l) { gs(p.h, p.w_in_t + (size_t)l * NPAD * D, TT, NPAD, D, pg8::EpiWin{p.proj, p.dt}); }
    void gemm_merge(int l, int rows) {
        const bf16* g = p.proj + PC_G; const float* bg = p.b_gate + (size_t)l * 3 * D;
        gs(p.ossd, p.w_ssd_t + (size_t)l * D * 1024, rows, D, 1024, pg8::EpiMerge<0>{g, bg, p.macc, p.m});
        gs(p.oswa, p.w_swa_t + (size_t)l * D * 512, rows, D, 512, pg8::EpiMerge<1>{g + 1024, bg + 1024, p.macc, p.m});
        gs(p.ona, p.w_na_t + (size_t)l * D * 512, rows, D, 512, pg8::EpiMerge<2>{g + 2048, bg + 2048, p.macc, p.m}); }
    void gemm_wout(int l, int rows) { gs(p.m, p.w_out_t + (size_t)l * D * D, rows, D, D, pg8::EpiWout{p.xl, p.mod + (size_t)l * (NB + 1) * 6 * D}); }
    void gemm_moe1(int l) { gt(p.xs, p.w1_t + (size_t)l * NE * 2048 * D, D, p.units1, p.nunits, pg8::EpiMoe1{p.act, p.moe_b1 + (size_t)l * NE * 2048}); }
    void gemm_moe2(int l) { gt(p.act, p.w2_t + (size_t)l * NE * D * D, D, p.units2, p.nunits + 1, pg8::EpiMoe2{p.ys, p.moe_b2 + (size_t)l * NE * D}); }
};

extern "C" void kernel_launch(void* const* d_in, const int* in_sizes, int n_in, void* d_out, int out_size, void* d_ws, size_t ws_size, hipStream_t stream) {
    P p{}; bind_inputs(p, d_in, d_out);
    const size_t need = carve_ws(p, (char*)d_ws);
    if (n_in != 29 || need > ws_size) { fprintf(stderr, "kernel_launch: need %zu bytes of workspace, have %zu (n_in %d)\n", need, ws_size, n_in); return; }
    (void)hipMemsetAsync(p.ctl, 0, 1 << 20, stream);
    DevEx ex{p, stream};
    forward(ex, p);
}
#endif
```

```cpp
#ifndef HOST_EMU
#include <hip/hip_runtime.h>
#include <cstdio>
#include <cstdint>
#define HD __host__ __device__ __forceinline__
#else
#include <cstdio>
#include <cstdint>
#include <cstring>
#include <cmath>
#include <cstdlib>
#define HD inline
struct uint4 { unsigned x, y, z, w; };
struct float4 { float x, y, z, w; };
#endif

typedef unsigned short bf16;

#ifndef NB_
#define NB_ 8
#define NL_ 4
#endif
constexpr int NB = NB_, NL = NL_;
constexpr int S = 2048, LC = 256, D = 1024, GW = 64;
constexpr int NPROJ = 7936, NPAD = 8192;
constexpr int PC_Z = 0, PC_XBC = 1024, PC_QS = 2560, PC_KS = 3072, PC_VS = 3200, PC_QN = 3328, PC_KN = 3840, PC_VN = 4352, PC_G = 4864;
constexpr int NE = 32, TOPK = 4;
constexpr float NORM_EPS = 1e-6f;
constexpr int TL = NB * S, TC = NB * LC, TT = TL + TC, NSLOT = TT * 4 + NE * 256;

struct P {
    const float *x, *c, *ctx, *c_ctx, *w_ada, *b_ada, *w_in, *w_br_ssd, *w_br_swa, *w_br_na, *w_out, *moe_w1, *moe_w2;
    const float* small_in[16];
    float* out; char* ws;
};
#define WS_LIST(X) \
    X(ctl, unsigned, (size_t)1 << 20) \
    X(xl, float, (size_t)TT * D * 4) X(mod, float, (size_t)NL * (NB + 1) * 6 * D * 4) X(dt, float, (size_t)TT * 32 * 4) \
    X(yf, float, (size_t)TT * 1024 * 4) X(yb, float, (size_t)TT * 1024 * 4) X(macc, float, (size_t)TT * D * 4) X(topw, float, (size_t)TT * 4 * 4) \
    X(h, bf16, (size_t)TT * D * 2) X(proj, bf16, (size_t)TT * NPROJ * 2) X(xa, bf16, (size_t)TT * 1536 * 2) X(qsr, bf16, (size_t)TL * 512 * 2) X(ksr, bf16, (size_t)TL * 128 * 2) \
    X(ossd, bf16, (size_t)TT * 1024 * 2) X(oswa, bf16, (size_t)TT * 512 * 2) X(ona, bf16, (size_t)TT * 512 * 2) X(m, bf16, (size_t)TT * D * 2) \
    X(xs, bf16, (size_t)NSLOT * D * 2) X(act, bf16, (size_t)NSLOT * D * 2) X(ys, bf16, (size_t)NSLOT * D * 2) \
    X(topi, int, (size_t)TT * 4 * 4) X(slot_of, int, (size_t)TT * 4 * 4) X(cnt, int, 4096) X(cursor, int, 4096) X(pstart, int, 4096) X(nunits, int, 4096) \
    X(slot_tok, int, (size_t)NSLOT * 4) X(stok2, int, (size_t)NE * TT * 4) X(units1, int, (size_t)(NSLOT / 256) * 8 * 4) X(units2, int, (size_t)(NSLOT / 256) * 4 * 4) \
    X(w_in_t, bf16, (size_t)NL * NPAD * D * 2) X(w_ssd_t, bf16, (size_t)NL * D * 1024 * 2) X(w_swa_t, bf16, (size_t)NL * D * 512 * 2) X(w_na_t, bf16, (size_t)NL * D * 512 * 2) \
    X(h8n, unsigned char, (size_t)TT * 1024) X(gate8, unsigned char, (size_t)TT * 3072) X(w_g8, unsigned char, (size_t)NL * 3072 * 1024) X(h8, unsigned char, (size_t)TT * 1024) X(act8, unsigned char, (size_t)NSLOT * 1024) X(w1_8, unsigned char, (size_t)NL * NE * 2048 * 1024) X(w2_8, unsigned char, (size_t)NL * NE * 1024 * 1024) X(ident, int, (size_t)NSLOT * 4) X(n2_gm, float, (size_t)NL * 9 * 1024 * 4) X(n2_c, float, (size_t)NL * 9 * 32 * 4) X(n2_wh, bf16, (size_t)NL * 32 * 2 * 64 * 8 * 2) X(n2_wl, bf16, (size_t)NL * 32 * 2 * 64 * 8 * 2) X(sstab, float, (size_t)NB * 18 * 16 * 1536 * 4) X(ssq, float, (size_t)TT * 32 * 4) X(rstd, float, (size_t)TT * 4) X(router_wT, float, (size_t)NL * NE * D * 4) X(rope_tab, float, 64 * 16 * 2 * 4) X(sloc, bf16, (size_t)NB * 18 * 16 * 2 * 8192 * 2) X(sdec, float, (size_t)NB * 18 * 16 * 2 * 4) X(hin, bf16, (size_t)NB * 18 * 16 * 2 * 8192 * 2) X(w_out_t, bf16, (size_t)NL * D * D * 2) X(w1_t, bf16, (size_t)NL * NE * 2048 * D * 2) X(w2_t, bf16, (size_t)NL * NE * D * D * 2) \
    SMALL_LIST(X)
#define SMALL_LIST(X) \
    X(norm1_g, float, (size_t)NL * D * 4) X(norm2_g, float, (size_t)NL * D * 4) X(b_gate, float, (size_t)NL * 3 * D * 4) X(conv_w, float, (size_t)NL * 5 * 1536 * 4) X(conv_b, float, (size_t)NL * 1536 * 4) \
    X(a_log, float, (size_t)NL * 32 * 4) X(dt_bias, float, (size_t)NL * 32 * 4) X(ssd_d, float, (size_t)NL * 16 * 4) X(ssd_norm_g, float, (size_t)NL * 1024 * 4) X(swa_sink, float, (size_t)NL * 8 * 4) \
    X(na_rpb, float, (size_t)NL * 8 * 15 * 31 * 4) X(router_w, float, (size_t)NL * D * NE * 4) X(router_b, float, (size_t)NL * NE * 4) X(moe_b1, float, (size_t)NL * NE * 2048 * 4) X(moe_b2, float, (size_t)NL * NE * D * 4) X(final_g, float, (size_t)D * 4)
constexpr int SMALL_IDX[16] = {4, 5, 9, 10, 11, 12, 13, 14, 15, 16, 17, 22, 23, 25, 27, 28};
#define X(name, T, bytes) WS_##name,
enum { WS_LIST(X) WS_COUNT };
#undef X
#define X(name, T, bytes) (bytes),
constexpr size_t WS_SIZES[WS_COUNT] = { WS_LIST(X) };
#undef X
constexpr size_t ws_off(int i) { size_t o = 0; for (int k = 0; k < i; ++k) o += (WS_SIZES[k] + 4095) & ~(size_t)4095; return o; }
constexpr size_t WS_TOTAL = ws_off(WS_COUNT);
#define X(name, T, bytes) HD T* name##_(const P& p) { constexpr size_t o = ws_off(WS_##name); return (T*)(p.ws + o); }
WS_LIST(X)
#undef X
constexpr int WS_SMALL0 = WS_norm1_g;
static void bind_inputs(P& p, void* const* d_in, void* d_out, void* ws) {
    const int big[13] = {0, 1, 2, 3, 6, 7, 8, 18, 19, 20, 21, 24, 26}; const float** f = (const float**)&p.x;
    for (int i = 0; i < 13; ++i) f[i] = (const float*)d_in[big[i]];
    for (int i = 0; i < 16; ++i) p.small_in[i] = (const float*)d_in[SMALL_IDX[i]];
    p.out = (float*)d_out; p.ws = (char*)ws;
}

HD unsigned f2u(float f) { unsigned u; __builtin_memcpy(&u, &f, 4); return u; }
HD float u2f(unsigned u) { float f; __builtin_memcpy(&f, &u, 4); return f; }
HD bf16 f2bf(float f) { unsigned u = f2u(f); return (bf16)((u + 0x7fffu + ((u >> 16) & 1u)) >> 16); }
HD float bf2f(bf16 b) { return u2f(((unsigned)b) << 16); }
HD unsigned pk2(float lo, float hi) { return (unsigned)f2bf(lo) | ((unsigned)f2bf(hi) << 16); }
#if defined(__HIP_DEVICE_COMPILE__)
HD float fexp_(float x) { return __builtin_amdgcn_exp2f(x * 1.4426950408889634f); }
HD float sigmoidf_(float x) { return __builtin_amdgcn_rcpf(1.f + fexp_(-x)); }
HD float siluf_(float x) { return x * __builtin_amdgcn_rcpf(1.f + fexp_(-x)); }
HD float softplusf_(float x) { return x > 20.f ? x : __builtin_amdgcn_logf(1.f + fexp_(x)) * 0.6931471805599453f; }
#else
HD float fexp_(float x) { return expf(x); }
HD float sigmoidf_(float x) { return 1.f / (1.f + expf(-x)); }
HD float siluf_(float x) { return x / (1.f + expf(-x)); }
HD float softplusf_(float x) { return x > 20.f ? x : log1pf(expf(x)); }
#endif
HD void ld8(const bf16* p, float* o) {
    const uint4 v = *(const uint4*)p;
    o[0] = u2f(v.x << 16); o[1] = u2f(v.x & 0xffff0000u); o[2] = u2f(v.y << 16); o[3] = u2f(v.y & 0xffff0000u);
    o[4] = u2f(v.z << 16); o[5] = u2f(v.z & 0xffff0000u); o[6] = u2f(v.w << 16); o[7] = u2f(v.w & 0xffff0000u);
}
HD void st8(bf16* p, const float* v) { uint4 o; o.x = pk2(v[0], v[1]); o.y = pk2(v[2], v[3]); o.z = pk2(v[4], v[5]); o.w = pk2(v[6], v[7]); *(uint4*)p = o; }
HD int mod_row(int r) { return r < TL ? r / S : NB; }
HD const float* mod_ptr(const P& p, int l, int r, int chunk) { return mod_(p) + ((size_t)(l * (NB + 1) + mod_row(r)) * 6 + chunk) * D; }
HD int win_src(int n) { return n < 2560 ? n : n < 7936 ? n + 32 : n < 7968 ? n - 7936 + 2560 : -1; }
HD int w1_src(int n) { const int j = n >> 8, i = n & 255; return i < 128 ? 128 * j + i : 1024 + 128 * j + (i - 128); }
#ifdef HOST_EMU
static inline int atomic_add_i(int* p, int v) { return __atomic_fetch_add(p, v, __ATOMIC_RELAXED); }
#else
__device__ __forceinline__ int atomic_add_i(int* p, int v) { return atomicAdd(p, v); }
#endif

struct FInit { P p; HD void operator()(long i) const {
    const long e = i * 16; const float* src = e < (long)TL * D ? p.x + e : p.ctx + (e - (long)TL * D); const float4 a = *(const float4*)src, b = *(const float4*)(src + 4), c = *(const float4*)(src + 8), d = *(const float4*)(src + 12);
    float* dst = xl_(p) + e; *(float4*)dst = a; *(float4*)(dst + 4) = b; *(float4*)(dst + 8) = c; *(float4*)(dst + 12) = d; } };

struct FCopySmall { P p; HD void operator()(long i) const {
    long o = i;
#define X(name, T, bytes) { constexpr long n_ = (long)((bytes) / 4); if (o >= 0 && o < n_) name##_(p)[o] = p.small_in[WS_##name - WS_SMALL0][o]; o -= n_; }
    SMALL_LIST(X)
#undef X
} };
#define X(name, T, bytes) + (long)((bytes) / 4)
constexpr long SMALL_FLOATS = 0 SMALL_LIST(X);
#undef X

struct FAda { P p; HD void operator()(long i) const {
    const int l = (int)(i / (6 * D)), col = (int)(i % (6 * D)); const float* w = p.w_ada + (size_t)l * D * 6 * D + col;
    float acc[9];
#pragma unroll
    for (int r = 0; r < 9; ++r) acc[r] = 0.f;
    for (int k = 0; k < D; ++k) { const float wv = w[(size_t)k * 6 * D];
#pragma unroll
        for (int r = 0; r < 9; ++r) { if (r <= NB) { const float cv = r < NB ? p.c[r * D + k] : p.c_ctx[k]; acc[r] += siluf_(cv) * wv; } } }
#pragma unroll
    for (int r = 0; r < 9; ++r) if (r <= NB) mod_(p)[((size_t)(l * (NB + 1) + r)) * 6 * D + col] = acc[r] + p.b_ada[(size_t)l * 6 * D + col]; } };

HD void moe_combine_row(const P& p, int lp, int r) {
    const float* g2 = mod_ptr(p, lp, r, 5); float* xr = xl_(p) + (size_t)r * D;
    const int s0 = slot_of_(p)[r * 4 + 0], s1 = slot_of_(p)[r * 4 + 1], s2 = slot_of_(p)[r * 4 + 2], s3 = slot_of_(p)[r * 4 + 3];
    const float w0 = topw_(p)[r * 4 + 0], w1 = topw_(p)[r * 4 + 1], w2 = topw_(p)[r * 4 + 2], w3 = topw_(p)[r * 4 + 3];
    for (int k = 0; k < D; k += 8) { float a[8], b[8], c[8], d[8];
        ld8(ys_(p) + (size_t)s0 * D + k, a); ld8(ys_(p) + (size_t)s1 * D + k, b); ld8(ys_(p) + (size_t)s2 * D + k, c); ld8(ys_(p) + (size_t)s3 * D + k, d);
        for (int j = 0; j < 8; ++j) xr[k + j] += g2[k + j] * (((w0 * a[j] + w1 * b[j]) + w2 * c[j]) + w3 * d[j]); } }

struct FNorm1 { P p; int l, combine; HD void operator()(long i) const {
    const int r = (int)i; if (r < NE) { cnt_(p)[r] = 0; cursor_(p)[r] = 0; }
    if (combine) moe_combine_row(p, l - 1, r);
    const float* xr = xl_(p) + (size_t)r * D; float ss = 0.f;
    for (int k = 0; k < D; ++k) ss += xr[k] * xr[k];
    const float rstd = 1.f / sqrtf(ss * (1.f / D) + NORM_EPS);
    const float* sh = mod_ptr(p, l, r, 0); const float* sc = mod_ptr(p, l, r, 1); const float* g = norm1_g_(p) + (size_t)l * D;
    for (int k = 0; k < D; k += 8) { float v[8];
        for (int j = 0; j < 8; ++j) v[j] = xr[k + j] * rstd * g[k + j] * (1.f + sc[k + j]) + sh[k + j];
        st8(h_(p) + (size_t)r * D + k, v); } } };

struct FConv { P p; int l, pad; HD void operator()(long i) const {
    const int r = (int)(i / 1536), ch = (int)(i % 1536); int lo, hi;
    if (r < TL) { lo = (r / S) * S; hi = lo + S; } else { lo = TL + ((r - TL) / LC) * LC; hi = lo + LC; }
    float acc = conv_b_(p)[l * 1536 + ch];
    for (int j = 0; j < 5; ++j) { const int rr = r + j - 2; if (rr >= lo && rr < hi) acc += conv_w_(p)[(l * 5 + j) * 1536 + ch] * bf2f(proj_(p)[(size_t)rr * NPROJ + PC_XBC + ch]); }
    xa_(p)[(size_t)r * 1536 + ch] = f2bf(siluf_(acc)); } };

struct FRouterT { P p; HD void operator()(long i) const {
    const int k = (int)(i % D), e = (int)((i / D) % NE), l = (int)(i / ((long)D * NE)); router_wT_(p)[i] = p.small_in[WS_router_w - WS_SMALL0][((size_t)l * D + k) * NE + e]; } };
struct FConv8 { P p; int l, pad; HD void operator()(long i) const {
    const int r = (int)(i / 192), ch = (int)(i % 192) * 8; int lo, hi;
    if (r < TL) { lo = (r / S) * S; hi = lo + S; } else { lo = TL + ((r - TL) / LC) * LC; hi = lo + LC; }
    float acc[8];
    for (int q = 0; q < 8; ++q) acc[q] = conv_b_(p)[l * 1536 + ch + q];
    for (int j = 0; j < 5; ++j) { const int rr = r + j - 2; if (rr >= lo && rr < hi) { float xv[8]; ld8(proj_(p) + (size_t)rr * NPROJ + PC_XBC + ch, xv); const float* w = conv_w_(p) + (l * 5 + j) * 1536 + ch;
            for (int q = 0; q < 8; ++q) acc[q] += w[q] * xv[q]; } }
    for (int q = 0; q < 8; ++q) acc[q] = siluf_(acc[q]);
    st8(xa_(p) + (size_t)r * 1536 + ch, acc); } };
struct FRopeTab { P p; HD void operator()(long i) const {
    const int i16 = (int)(i & 15), pos = (int)(i >> 4); const float inv = expf(-(float)(2 * i16) * (1.f / 32.f) * 9.210340371976184f), ang = (float)pos * inv;
    rope_tab_(p)[2 * i] = cosf(ang); rope_tab_(p)[2 * i + 1] = sinf(ang); } };
struct FConvBlk { P p; int l, pad; HD void operator()(long i) const {
    const int cg = (int)(i % 192), r0 = (int)(i / 192) * 8, ch = cg * 8; int lo, hi;
    if (r0 < TL) { lo = (r0 / S) * S; hi = lo + S; } else { lo = TL + ((r0 - TL) / LC) * LC; hi = lo + LC; }
    uint4 xr[12];
#pragma unroll
    for (int k = 0; k < 12; ++k) { const int rr = r0 + k - 2; const int rc = rr < lo ? lo : (rr >= hi ? hi - 1 : rr); xr[k] = *(const uint4*)(proj_(p) + (size_t)rc * NPROJ + PC_XBC + ch); }
    float w[5][8], bs[8];
#pragma unroll
    for (int j = 0; j < 5; ++j)
#pragma unroll
        for (int q = 0; q < 8; ++q) w[j][q] = conv_w_(p)[(l * 5 + j) * 1536 + ch + q];
#pragma unroll
    for (int q = 0; q < 8; ++q) bs[q] = conv_b_(p)[l * 1536 + ch + q];
    float xf[12][8];
#pragma unroll
    for (int k = 0; k < 12; ++k) { const int rr = r0 + k - 2; const bool ok = rr >= lo && rr < hi; const unsigned wd[4] = {xr[k].x, xr[k].y, xr[k].z, xr[k].w};
#pragma unroll
        for (int q = 0; q < 8; ++q) xf[k][q] = ok ? u2f((q & 1) ? (wd[q >> 1] & 0xffff0000u) : (wd[q >> 1] << 16)) : 0.f; }
#pragma unroll
    for (int o = 0; o < 8; ++o) { float acc[8];
#pragma unroll
        for (int q = 0; q < 8; ++q) { float a = bs[q];
#pragma unroll
            for (int j = 0; j < 5; ++j) a += w[j][q] * xf[o + j][q];
            acc[q] = siluf_(a); }
        st8(xa_(p) + (size_t)(r0 + o) * 1536 + ch, acc); } } };
struct FRope { P p; HD void operator()(long i) const {
    const int hf = (int)(i & 1); const long q = i >> 1; const int j = (int)(q % 10), r = (int)(q / 10);
    const int s = r % S, pos = hf == 0 ? s / GW : s % GW; const float* tb = rope_tab_(p) + pos * 32;
    const bf16* src; bf16* dst;
    if (j < 8) { src = proj_(p) + (size_t)r * NPROJ + PC_QS + j * 64 + hf * 32; dst = qsr_(p) + (size_t)r * 512 + j * 64 + hf * 32; }
    else { src = proj_(p) + (size_t)r * NPROJ + PC_KS + (j - 8) * 64 + hf * 32; dst = ksr_(p) + (size_t)r * 128 + (j - 8) * 64 + hf * 32; }
    float u1[16], u2[16], o1[16], o2[16]; ld8(src, u1); ld8(src + 8, u1 + 8); ld8(src + 16, u2); ld8(src + 24, u2 + 8);
#pragma unroll
    for (int k = 0; k < 16; ++k) { const float cs = tb[2 * k], sn = tb[2 * k + 1]; o1[k] = u1[k] * cs - u2[k] * sn; o2[k] = u2[k] * cs + u1[k] * sn; }
    st8(dst, o1); st8(dst + 8, o1 + 8); st8(dst + 16, o2); st8(dst + 24, o2 + 8); } };

struct FScan { P p; int l, pad; HD void operator()(long i) const {
    const int pp = (int)(i & 63), dir = (int)((i >> 6) & 1), hh = (int)((i >> 7) & 15), b = (int)(i >> 11);
    const float A = -expf(a_log_(p)[(l * 2 + dir) * 16 + hh]), bias = dt_bias_(p)[(l * 2 + dir) * 16 + hh]; const int g = hh >> 3;
    float st[128];
#pragma unroll
    for (int n = 0; n < 128; ++n) st[n] = 0.f;
    float* yo = dir ? yb_(p) : yf_(p);
    for (int step = 0; step < LC + S; ++step) {
        int r;
        if (dir == 0) r = step < LC ? TL + b * LC + step : b * S + (step - LC);
        else r = step < LC ? TL + b * LC + (LC - 1 - step) : b * S + (S - 1 - (step - LC));
        const float dtv = softplusf_(dt_(p)[(size_t)r * 32 + dir * 16 + hh] + bias), a = expf(dtv * A), xv = bf2f(xa_(p)[(size_t)r * 1536 + hh * 64 + pp]) * dtv;
        const bf16* Bp = xa_(p) + (size_t)r * 1536 + 1024 + g * 128; const bf16* Cp = Bp + 256; float y = 0.f;
#pragma unroll
        for (int n = 0; n < 128; n += 8) { float bv[8], cv[8]; ld8(Bp + n, bv); ld8(Cp + n, cv);
#pragma unroll
            for (int j = 0; j < 8; ++j) { st[n + j] = a * st[n + j] + xv * bv[j]; y += st[n + j] * cv[j]; } }
        yo[(size_t)r * 1024 + hh * 64 + pp] = y; } } };

struct FSsdOut { P p; int l, pad; HD void operator()(long i) const {
    const int r = (int)i; float ss = 0.f;
    for (int ch = 0; ch < 1024; ++ch) { const float y = (yf_(p)[(size_t)r * 1024 + ch] + yb_(p)[(size_t)r * 1024 + ch] + ssd_d_(p)[l * 16 + (ch >> 6)] * bf2f(xa_(p)[(size_t)r * 1536 + ch])) * siluf_(bf2f(proj_(p)[(size_t)r * NPROJ + PC_Z + ch])); ss += y * y; }
    const float rstd = 1.f / sqrtf(ss * (1.f / 1024.f) + NORM_EPS);
    for (int ch = 0; ch < 1024; ++ch) { const float y = (yf_(p)[(size_t)r * 1024 + ch] + yb_(p)[(size_t)r * 1024 + ch] + ssd_d_(p)[l * 16 + (ch >> 6)] * bf2f(xa_(p)[(size_t)r * 1536 + ch])) * siluf_(bf2f(proj_(p)[(size_t)r * NPROJ + PC_Z + ch]));
        ossd_(p)[(size_t)r * 1024 + ch] = f2bf(y * rstd * ssd_norm_g_(p)[l * 1024 + ch]); } } };

#define ATT_KEY(kptr, vptr, extra) do { float sc_ = 0.f; \
    _Pragma("unroll") for (int d_ = 0; d_ < 64; d_ += 8) { float kv_[8]; ld8((kptr) + d_, kv_); _Pragma("unroll") for (int j_ = 0; j_ < 8; ++j_) sc_ += q[d_ + j_] * kv_[j_]; } \
    sc_ = sc_ * 0.125f + (extra); const float mn_ = sc_ > mx ? sc_ : mx; const float cf_ = expf(mx - mn_), pe_ = expf(sc_ - mn_); den = den * cf_ + pe_; mx = mn_; \
    _Pragma("unroll") for (int d_ = 0; d_ < 64; d_ += 8) { float vv_[8]; ld8((vptr) + d_, vv_); _Pragma("unroll") for (int j_ = 0; j_ < 8; ++j_) o[d_ + j_] = o[d_ + j_] * cf_ + pe_ * vv_[j_]; } } while (0)

struct FSwa { P p; int l, pad; HD void operator()(long i) const {
    const int hq = (int)(i & 7), r = (int)(i >> 3), kvh = hq >> 2; const float sink = swa_sink_(p)[l * 8 + hq];
    float q[64], o[64]; float mx = sink, den = 1.f;
#pragma unroll
    for (int d = 0; d < 64; ++d) o[d] = 0.f;
    int b;
    if (r < TL) { b = r / S; const int s = r % S;
#pragma unroll
        for (int d = 0; d < 64; d += 8) ld8(qsr_(p) + (size_t)r * 512 + hq * 64 + d, q + d);
        const int j0 = s - 128 < 0 ? 0 : s - 128, j1 = s + 128 > S - 1 ? S - 1 : s + 128;
        for (int j = j0; j <= j1; ++j) { const size_t rr = (size_t)b * S + j; ATT_KEY(ksr_(p) + rr * 128 + kvh * 64, proj_(p) + rr * NPROJ + PC_VS + kvh * 64, 0.f); }
    } else { b = (r - TL) / LC;
#pragma unroll
        for (int d = 0; d < 64; d += 8) ld8(proj_(p) + (size_t)r * NPROJ + PC_QS + hq * 64 + d, q + d); }
    for (int cj = 0; cj < LC; ++cj) { const size_t rr = (size_t)TL + (size_t)b * LC + cj; ATT_KEY(proj_(p) + rr * NPROJ + PC_KS + kvh * 64, proj_(p) + rr * NPROJ + PC_VS + kvh * 64, 0.f); }
    const float inv = 1.f / den;
#pragma unroll
    for (int d = 0; d < 64; d += 8) { float v[8];
#pragma unroll
        for (int j = 0; j < 8; ++j) v[j] = o[d + j] * inv;
        st8(oswa_(p) + (size_t)r * 512 + hq * 64 + d, v); } } };

struct FNa { P p; int l, pad; HD void operator()(long i) const {
    const int hh = (int)(i & 7), r = (int)(i >> 3);
    float q[64], o[64]; float mx = -1e30f, den = 0.f;
#pragma unroll
    for (int d = 0; d < 64; ++d) o[d] = 0.f;
#pragma unroll
    for (int d = 0; d < 64; d += 8) ld8(proj_(p) + (size_t)r * NPROJ + PC_QN + hh * 64 + d, q + d);
    int b;
    if (r < TL) { b = r / S; const int s = r % S, qr = s / GW, qc = s % GW;
        int r0 = qr - 4; r0 = r0 < 0 ? 0 : (r0 > 24 ? 24 : r0); int c0 = qc - 8; c0 = c0 < 0 ? 0 : (c0 > 48 ? 48 : c0);
        const float* rpb = na_rpb_(p) + (size_t)(l * 8 + hh) * 15 * 31;
        for (int kr = r0; kr < r0 + 8; ++kr) for (int kc = c0; kc < c0 + 16; ++kc) { const size_t rr = (size_t)b * S + kr * GW + kc;
            const float bias = rpb[(kr - qr + 7) * 31 + (kc - qc + 15)];
            ATT_KEY(proj_(p) + rr * NPROJ + PC_KN + hh * 64, proj_(p) + rr * NPROJ + PC_VN + hh * 64, bias); }
    } else b = (r - TL) / LC;
    for (int cj = 0; cj < LC; ++cj) { const size_t rr = (size_t)TL + (size_t)b * LC + cj; ATT_KEY(proj_(p) + rr * NPROJ + PC_KN + hh * 64, proj_(p) + rr * NPROJ + PC_VN + hh * 64, 0.f); }
    const float inv = 1.f / den;
#pragma unroll
    for (int d = 0; d < 64; d += 8) { float v[8];
#pragma unroll
        for (int j = 0; j < 8; ++j) v[j] = o[d + j] * inv;
        st8(ona_(p) + (size_t)r * 512 + hh * 64 + d, v); } } };

struct FNorm2 { P p; int l, pad; HD void operator()(long i) const {
    const int r = (int)i; const float* xr = xl_(p) + (size_t)r * D; float ss = 0.f;
    for (int k = 0; k < D; ++k) ss += xr[k] * xr[k];
    const float rstd = 1.f / sqrtf(ss * (1.f / D) + NORM_EPS);
    const float* sh = mod_ptr(p, l, r, 3); const float* sc = mod_ptr(p, l, r, 4); const float* g = norm2_g_(p) + (size_t)l * D; const float* rw = router_w_(p) + (size_t)l * D * NE;
    float lg[NE];
#pragma unroll
    for (int e = 0; e < NE; ++e) lg[e] = router_b_(p)[l * NE + e];
    for (int k = 0; k < D; k += 8) { float v[8];
        for (int j = 0; j < 8; ++j) { v[j] = xr[k + j] * rstd * g[k + j] * (1.f + sc[k + j]) + sh[k + j]; const float* w = rw + (size_t)(k + j) * NE;
#pragma unroll
            for (int e = 0; e < NE; ++e) lg[e] += v[j] * w[e]; }
        st8(h_(p) + (size_t)r * D + k, v); }
    float tv[4]; int ti[4];
#pragma unroll
    for (int j = 0; j < 4; ++j) { float best = -3e38f; int bi = 0;
#pragma unroll
        for (int e = 0; e < NE; ++e) if (lg[e] > best) { best = lg[e]; bi = e; }
#pragma unroll
        for (int e = 0; e < NE; ++e) if (e == bi) lg[e] = -3e38f;
        tv[j] = best; ti[j] = bi; }
    const float e1 = expf(tv[1] - tv[0]), e2 = expf(tv[2] - tv[0]), e3 = expf(tv[3] - tv[0]), inv = 1.f / (1.f + e1 + e2 + e3);
    topw_(p)[r * 4 + 0] = inv; topw_(p)[r * 4 + 1] = e1 * inv; topw_(p)[r * 4 + 2] = e2 * inv; topw_(p)[r * 4 + 3] = e3 * inv;
#pragma unroll
    for (int j = 0; j < 4; ++j) { topi_(p)[r * 4 + j] = ti[j]; atomic_add_i(cnt_(p) + ti[j], 1); } } };

struct FPlan { P p; HD void operator()(long) const {
    int tot = 0, n1 = 0, n2 = 0;
    for (int e = 0; e < NE; ++e) { const int c = cnt_(p)[e], nt = (c + 255) >> 8; pstart_(p)[e] = tot;
        for (int rt = 0; rt < nt; ++rt) { const int pm = (tot >> 8) + rt;
            for (int j = 0; j < 8; ++j) units1_(p)[n1++] = (pm << 16) | (e * 8 + j);
            for (int j = 0; j < 4; ++j) units2_(p)[n2++] = (pm << 16) | (e * 4 + j); }
        tot += nt << 8; }
    pstart_(p)[NE] = tot; nunits_(p)[0] = n1; nunits_(p)[1] = n2; } };
struct FSlotInit { P p; HD void operator()(long i) const { slot_tok_(p)[i] = -1; } };
struct FAssign { P p; HD void operator()(long i) const {
    const int e = topi_(p)[i], pos = atomic_add_i(cursor_(p) + e, 1), slot = pstart_(p)[e] + pos; slot_of_(p)[i] = slot; slot_tok_(p)[slot] = (int)(i >> 2); } };
struct FGather { P p; HD void operator()(long i) const {
    const int slot = (int)(i >> 7), c8 = (int)(i & 127) * 8; if (slot >= pstart_(p)[NE]) return; const int t = slot_tok_(p)[slot];
    uint4 v; v.x = v.y = v.z = v.w = 0u; if (t >= 0) v = *(const uint4*)(h_(p) + (size_t)t * D + c8); *(uint4*)(xs_(p) + (size_t)slot * D + c8) = v; } };

struct FFinal { P p; HD void operator()(long i) const {
    const int r = (int)i; moe_combine_row(p, NL - 1, r);
    const float* xr = xl_(p) + (size_t)r * D; float ss = 0.f;
    for (int k = 0; k < D; ++k) ss += xr[k] * xr[k];
    const float rstd = 1.f / sqrtf(ss * (1.f / D) + NORM_EPS);
    for (int k = 0; k < D; ++k) p.out[(size_t)r * D + k] = xr[k] * rstd * final_g_(p)[k]; } };

HD float swiglu_(float g, float u) { g = g < 7.f ? g : 7.f; u = u < -7.f ? -7.f : (u > 7.f ? 7.f : u); return (u + 1.f) * g * sigmoidf_(1.702f * g); }

#ifdef HOST_EMU
#define FWD_ATTR static
#define LAUNDER(x)
#else
#define LAUNDER(x) do { size_t z_ = 0; asm volatile("" : "+s"(z_)); (x) = p0.ws + z_; } while (0)
#define FWD_ATTR __device__ __forceinline__
#endif
template <class Ex> FWD_ATTR void forward(Ex& ex, const P& p0) {
    P p = p0;
    ex.ph_prologue(p);
    for (int l = 0; l < NL; ++l) {
        LAUNDER(p.ws);
        const bool last = (l == NL - 1); const int rows = last ? TL : TT;
        ex.ph_norm1(p, l, l > 0 ? 1 : 0);
#ifdef PROBE_N1
        ex.ph_norm1(p, l, 0);
#endif
        ex.gemm_win(p, l);
        ex.ph_conv_rope(p, l);
        ex.ph_scan(p, l);
        ex.ph_mixers(p, l, rows);
        ex.gemm_merge(p, l, rows);
        ex.gemm_wout(p, l, rows);
#ifdef PROBE_WOUT
        ex.gemm_wout(p, l, rows, 0.f);
#endif
        ex.ph_norm2(p, l, rows);
#ifdef PROBE_N2
        ex.ph_norm2(p, l, rows, 0);
#endif
        ex.ph_moe_plan(p, l, rows);
        ex.gemm_moe1(p, l);
        ex.gemm_moe2(p, l);
    }
    LAUNDER(p.ws);
    ex.ph_final(p);
}
template <class Ex> struct ItemPhases {
    Ex& self() { return *static_cast<Ex*>(this); }
    void ph_prologue(const P& p) { self().prep_weights(p); self().items(SMALL_FLOATS, FCopySmall{p}); self().items((long)TT * D / 16, FInit{p}); self().items(1024, FRopeTab{p}); self().items((long)NL * 6 * D, FAda{p}); }
    void ph_norm1(const P& p, int l, int combine) { self().items(TT, FNorm1{p, l, combine}); }
    void ph_conv_rope(const P& p, int l) { self().items((long)(TT / 8) * 192, FConvBlk{p, l, 0}); self().items((long)TL * 10 * 2, FRope{p}); }
    void ph_scan(const P& p, int l) { self().items((long)NB * 16 * 2 * 64, FScan{p, l, 0}); }
    void ph_mixers(const P& p, int l, int rows) { self().items(rows, FSsdOut{p, l, 0}); self().items((long)rows * 8, FSwa{p, l, 0}); self().items((long)rows * 8, FNa{p, l, 0}); }
    void ph_norm2(const P& p, int l, int rows, int count = 1) { self().items(rows, FNorm2{p, l, 0}); }
    void ph_moe_plan(const P& p, int l, int rows) { self().items(1, FPlan{p}); self().items(NSLOT, FSlotInit{p}); self().items((long)rows * 4, FAssign{p}); self().items((long)NSLOT * 128, FGather{p}); }
    void ph_final(const P& p) { self().items(TL, FFinal{p}); }
};

#ifndef HOST_EMU
namespace pg8 {
#define PG8_LAS __attribute__((address_space(3)))
typedef unsigned short bf16_t;
typedef short bf16x8 __attribute__((ext_vector_type(8)));
typedef float f32x4 __attribute__((ext_vector_type(4)));
typedef unsigned u32x4 __attribute__((ext_vector_type(4)));
typedef int i32x4 __attribute__((ext_vector_type(4)));
constexpr int BM = 256, BK = 64, HALF = 128, HTB = HALF * BK * 2, STAGE_BYTES = 8 * HTB, NXCD = 8, WGM = 8;
__host__ __device__ __forceinline__ int lds_byte(int r, int c) { const int st = (r >> 4) * 2 + (c >> 5), rr = r & 15, cc = c & 31, ob = rr * 64 + cc * 2; return st * 1024 + (ob ^ (((ob >> 9) & 1) << 5)); }
__host__ __device__ __forceinline__ void stage_rc(int b, int& R, int& C) { const int st = b / 1024, sb = b % 1024, swz = sb ^ (((sb >> 9) & 1) << 5); R = (st >> 1) * 16 + swz / 64; C = (st & 1) * 32 + (swz % 64) / 2; }
__host__ __device__ __forceinline__ int perm32(int rho) { const int n = rho >> 4, i = rho & 15; return 8 * (i >> 2) + 4 * n + (i & 3); }
struct Unit { int pm, pn; };
struct Gemm { const bf16_t* A; const bf16_t* Bt; int M, N, K, pad; };
struct StaticOrder {
    int nM, nN, nwg, G, c;
    __host__ __device__ void init(int M, int N, int G_, int c_) { nM = M / BM; nN = N / BM; nwg = nM * nN; G = G_; c = c_; }
    __host__ __device__ bool next(int i, Unit& u) const {
        const long L = (long)i * G + c; if (L >= nwg) return false;
        int wgid = (int)L; { const int q = nwg / NXCD, r = nwg % NXCD, xcd = wgid % NXCD, off = wgid / NXCD; wgid = (xcd < r ? xcd * (q + 1) : r * (q + 1) + (xcd - r) * q) + off; }
        const int nig = WGM * nN, gid = wgid / nig, fm = gid * WGM, gsz = (nM - fm) < WGM ? (nM - fm) : WGM;
        u.pm = fm + ((wgid % nig) % gsz); u.pn = (wgid % nig) / gsz; return true;
    }
    __device__ __forceinline__ void a_ready(const Unit&) const {}
    __device__ __forceinline__ void done(const Unit&) const {}
};
struct StaticOrderG : StaticOrder { const int* rowmap; __device__ __forceinline__ int rbase(const Unit& u) const { return u.pm * BM; } };
struct WinOrder : StaticOrder {
    __device__ bool next(int i, Unit& u) const { if (!StaticOrder::next(i, u)) return false; if (u.pn == 19) u.pn = 31; return true; } };
struct TableOrder {
    const PG8_LAS int* te; const PG8_LAS int* tb; const int* rowmap; int n, G, c, sh;
    __device__ void bind(int G_, int c_, int nj) { G = G_; c = c_; if (G_ == 256) { const int x = c_ & 7, slot = c_ >> 3, rpx = 32 / nj; c = ((x * rpx + slot / nj) * nj) + slot % nj; } }
    __device__ bool next(int i, Unit& u) const { const long L = (long)i * G + c; if (L >= n) return false; const int pm = (int)L >> sh; u.pm = pm; u.pn = (te[pm] << sh) + ((int)L & ((1 << sh) - 1)); return true; }
    __device__ __forceinline__ int rbase(const Unit& u) const { return tb ? tb[u.pm] : u.pm * BM; }
    __device__ __forceinline__ void a_ready(const Unit&) const {}
    __device__ __forceinline__ void done(const Unit&) const {}
};
__device__ __forceinline__ unsigned cvt_pk_bf16(float lo, float hi) { unsigned r; asm volatile("v_cvt_pk_bf16_f32 %0, %1, %2" : "=v"(r) : "v"(lo), "v"(hi)); return r; }

template <class Epi, class Sched, bool ALIGN_EPI = false, bool SP2 = false, bool GATHER = false, bool FP8 = false, int SCW = 127, int SCX = 127>
__device__ __forceinline__ void gemm_phase(PG8_LAS unsigned char* lds, const Gemm g, const Sched& S, const Epi& E, const int wid_in) {
    unsigned z_ = 0u; asm volatile("" : "+v"(z_)); const int lane_ = (int)__builtin_amdgcn_mbcnt_hi(~0u, __builtin_amdgcn_mbcnt_lo(~0u, z_));
    const int wid = wid_in, tid = wid_in * 64 + lane_, lane = lane_, wr = wid >> 2, wc = wid & 3, fr = lane & 15, fq = lane >> 4;
    const int K = g.K, nt = K / BK;
    static_assert(!GATHER || SP2, "the gathered A path is written for the two-super-phase loop");
    unsigned voffA[2], voffB[2]; unsigned crowo[2][2] = {{0u, 0u}, {0u, 0u}};
#pragma unroll
    for (int i = 0; i < 2; ++i) { int R, C; stage_rc(tid * 16 + i * 8192, R, C); const int Rb = Epi::PERM ? ((R & ~31) + perm32(R & 31)) : R;
        voffA[i] = GATHER ? (unsigned)C * 2u : (unsigned)(R * K + C) * 2u; voffB[i] = (unsigned)(Rb * K + C) * 2u; }
    PG8_LAS unsigned char* glk = lds + 139264 + wid * 1024;
    const size_t kstep = (size_t)(BK * 2);
    const size_t hstep = (size_t)HALF * K * 2;
    const size_t tstep = 2 * hstep;
    const unsigned ldsw = (unsigned)wid * 1024u;
    const int aoff = lds_byte(wr * 64 + fr, fq * 8), boff = lds_byte(wc * 32 + fr, fq * 8);
#define PG8_SA(b, h) (((b) * 2 + (h)) * HTB)
#define PG8_SB(b, h) ((4 + (b) * 2 + (h)) * HTB)
#define PG8_STAGE(bufoff, gbase, voff) do { _Pragma("unroll") for (int _i = 0; _i < 2; ++_i) \
        __builtin_amdgcn_global_load_lds((const unsigned*)((const char*)(gbase) + (voff)[_i]), (PG8_LAS unsigned*)(lds + (bufoff) + ldsw + _i * 8192), 16, 0, 0); } while (0)
#define PG8_STAGE_A(bufoff, NX, koff, h) do { if constexpr (GATHER) { _Pragma("unroll") for (int _i = 0; _i < 2; ++_i) \
        __builtin_amdgcn_global_load_lds((const unsigned*)((const char*)g.A + (size_t)crowo[h][_i] + (koff) + voffA[_i]), (PG8_LAS unsigned*)(lds + (bufoff) + ldsw + _i * 8192), 16, 0, 0); } \
    else { PG8_STAGE(bufoff, ((NX) ? nA : cA) + (size_t)(h) * hstep + (koff), voffA); } } while (0)
#define PG8_LDA(dst, b, h) do { _Pragma("unroll") for (int m = 0; m < 4; ++m) _Pragma("unroll") for (int k = 0; k < 2; ++k) dst[m][k] = *(const PG8_LAS bf16x8*)(lds + PG8_SA(b, h) + aoff + m * 2048 + k * 1024); } while (0)
#define PG8_LDB(dst, b, h) do { _Pragma("unroll") for (int n = 0; n < 2; ++n) _Pragma("unroll") for (int k = 0; k < 2; ++k) dst[n][k] = *(const PG8_LAS bf16x8*)(lds + PG8_SB(b, h) + boff + n * 2048 + k * 1024); } while (0)
#define PG8_CAT(x) __builtin_shufflevector(__builtin_bit_cast(i32x4, (x)[0]), __builtin_bit_cast(i32x4, (x)[1]), 0, 1, 2, 3, 4, 5, 6, 7)
#define PG8_MMA(ai, bj, At, Bt) do { __builtin_amdgcn_s_setprio(1); if constexpr (FP8) { _Pragma("unroll") for (int m = 0; m < 4; ++m) _Pragma("unroll") for (int n = 0; n < 2; ++n) \
        acc[ai][bj][m][n] = __builtin_amdgcn_mfma_scale_f32_16x16x128_f8f6f4(PG8_CAT(Bt[n]), PG8_CAT(At[m]), acc[ai][bj][m][n], 0, 0, 0, SCW, 0, SCX); } \
    else { _Pragma("unroll") for (int m = 0; m < 4; ++m) _Pragma("unroll") for (int n = 0; n < 2; ++n) _Pragma("unroll") for (int k = 0; k < 2; ++k) \
        acc[ai][bj][m][n] = __builtin_amdgcn_mfma_f32_16x16x32_bf16(Bt[n][k], At[m][k], acc[ai][bj][m][n], 0, 0, 0); } __builtin_amdgcn_s_setprio(0); } while (0)
#define PG8_WAIT_V(n) asm volatile("s_waitcnt vmcnt(" #n ")" ::: "memory")
#define PG8_WAIT_L(n) asm volatile("s_waitcnt lgkmcnt(" #n ")" ::: "memory")
#define PG8_BAR __builtin_amdgcn_s_barrier()
#define PG8_SCHED __builtin_amdgcn_sched_barrier(0)
    Unit cur, nxt; int ui = 0;
    if (!S.next(0, cur)) return;
    f32x4 acc[2][2][4][2];
#pragma unroll
    for (int a = 0; a < 2; ++a)
#pragma unroll
        for (int b = 0; b < 2; ++b)
#pragma unroll
            for (int m = 0; m < 4; ++m)
#pragma unroll
                for (int n = 0; n < 2; ++n) acc[a][b][m][n] = (f32x4){0.f, 0.f, 0.f, 0.f};
    bf16x8 At[4][2], B0[2][2], B1[2][2];
    const char* cA = (const char*)g.A + (size_t)cur.pm * tstep; const char* cB = (const char*)g.Bt + (size_t)cur.pn * tstep;
    S.a_ready(cur);
    const char* nA = cA;
    if constexpr (GATHER) {
#pragma unroll
        for (int h = 0; h < 2; ++h)
#pragma unroll
            for (int i = 0; i < 2; ++i) { int R, C; stage_rc(tid * 16 + i * 8192, R, C); crowo[h][i] = (unsigned)S.rowmap[S.rbase(cur) + h * HALF + R] * (unsigned)(K * 2); }
    }
    if constexpr (SP2) {
        PG8_STAGE(PG8_SB(0, 0), cB, voffB); PG8_STAGE(PG8_SB(0, 1), cB + hstep, voffB); PG8_STAGE_A(PG8_SA(0, 0), false, 0, 0); PG8_STAGE_A(PG8_SA(0, 1), false, 0, 1);
        if (wr == 1) PG8_BAR;
        PG8_WAIT_V(2); PG8_BAR;
        PG8_STAGE(PG8_SB(1, 0), cB + kstep, voffB); PG8_STAGE_A(PG8_SA(1, 0), false, kstep, 0); PG8_STAGE(PG8_SB(1, 1), cB + hstep + kstep, voffB);
        PG8_WAIT_V(6); PG8_BAR;
    } else {
        PG8_STAGE(PG8_SB(0, 0), cB, voffB); PG8_STAGE(PG8_SA(0, 0), cA, voffA); PG8_STAGE(PG8_SB(0, 1), cB + hstep, voffB); PG8_STAGE(PG8_SA(0, 1), cA + hstep, voffA);
        if (wr == 1) PG8_BAR;
        PG8_WAIT_V(4); PG8_BAR;
        PG8_STAGE(PG8_SB(1, 0), cB + kstep, voffB); PG8_STAGE(PG8_SA(1, 0), cA + kstep, voffA); PG8_STAGE(PG8_SB(1, 1), cB + hstep + kstep, voffB);
        PG8_WAIT_V(6); PG8_BAR;
    }
    for (;;) {
        const bool has_next = S.next(ui + 1, nxt);
        nA = has_next ? (const char*)g.A + (size_t)nxt.pm * tstep : cA; const char* nB = has_next ? (const char*)g.Bt + (size_t)nxt.pn * tstep : cB;
        if constexpr (GATHER) { if (has_next) {
#pragma unroll
                for (int h = 0; h < 2; ++h)
#pragma unroll
                    for (int i = 0; i < 2; ++i) { int R, C; stage_rc(tid * 16 + i * 8192, R, C); __builtin_amdgcn_global_load_lds((const unsigned*)(S.rowmap + S.rbase(nxt) + h * HALF + R), (PG8_LAS unsigned*)(glk + (h * 2 + i) * 256), 4, 0, 0); } } }
#pragma unroll 1
        for (int t = 0; t < nt; t += 2) {
            const bool last = (t == nt - 2);
            const char* a1 = cA + (size_t)(t + 1) * kstep;
            const char* a2 = last ? nA : cA + (size_t)(t + 2) * kstep; const char* b2 = last ? nB : cB + (size_t)(t + 2) * kstep;
            const char* a3 = a2 + kstep; const char* b3 = b2 + kstep;
            if (last && has_next) S.a_ready(nxt);
            if constexpr (SP2) {
            const size_t k1 = (size_t)(t + 1) * kstep, k2 = last ? (size_t)0 : (size_t)(t + 2) * kstep, k3 = k2 + kstep;
            PG8_LDB(B0, 0, 0); PG8_LDB(B1, 0, 1); PG8_SCHED; PG8_LDA(At, 0, 0); PG8_STAGE_A(PG8_SA(1, 1), false, k1, 1);
            if constexpr (GATHER) { if (last && has_next) {
#pragma unroll
                    for (int h = 0; h < 2; ++h)
#pragma unroll
                        for (int i = 0; i < 2; ++i) crowo[h][i] = *(const PG8_LAS unsigned*)(glk + (h * 2 + i) * 256 + lane * 4) * (unsigned)(K * 2); } }
            PG8_WAIT_V(8); PG8_WAIT_L(0); PG8_BAR; PG8_MMA(0, 0, At, B0); PG8_MMA(0, 1, At, B1); PG8_BAR; PG8_SCHED;
            PG8_LDA(At, 0, 1); PG8_STAGE(PG8_SB(0, 0), b2, voffB); PG8_STAGE(PG8_SB(0, 1), b2 + hstep, voffB); PG8_STAGE_A(PG8_SA(0, 0), last, k2, 0);
            PG8_WAIT_V(8); PG8_WAIT_L(0); PG8_BAR; PG8_MMA(1, 0, At, B0); PG8_MMA(1, 1, At, B1); PG8_BAR; PG8_SCHED;
            PG8_LDB(B0, 1, 0); PG8_LDB(B1, 1, 1); PG8_SCHED; PG8_LDA(At, 1, 0); PG8_STAGE_A(PG8_SA(0, 1), last, k2, 1);
            PG8_WAIT_V(8); PG8_WAIT_L(0); PG8_BAR; PG8_MMA(0, 0, At, B0); PG8_MMA(0, 1, At, B1); PG8_BAR; PG8_SCHED;
            PG8_LDA(At, 1, 1); PG8_STAGE(PG8_SB(1, 0), b3, voffB); PG8_STAGE(PG8_SB(1, 1), b3 + hstep, voffB); PG8_STAGE_A(PG8_SA(1, 0), last, k3, 0);
            PG8_WAIT_V(8); PG8_WAIT_L(0); PG8_BAR; PG8_MMA(1, 0, At, B0); PG8_MMA(1, 1, At, B1); PG8_BAR; PG8_SCHED;
            } else {
            PG8_LDB(B0, 0, 0); PG8_SCHED; PG8_LDA(At, 0, 0); PG8_STAGE(PG8_SA(1, 1), a1 + hstep, voffA);
            PG8_WAIT_L(8); PG8_BAR; PG8_WAIT_L(0); PG8_MMA(0, 0, At, B0); PG8_BAR; PG8_SCHED;
            PG8_LDB(B1, 0, 1); PG8_STAGE(PG8_SB(0, 0), b2, voffB);
            PG8_BAR; PG8_WAIT_L(0); PG8_MMA(0, 1, At, B1); PG8_BAR;
            PG8_LDA(At, 0, 1); PG8_STAGE(PG8_SA(0, 0), a2, voffA);
            PG8_BAR; PG8_WAIT_L(0); PG8_MMA(1, 0, At, B0); PG8_BAR; PG8_SCHED;
            PG8_STAGE(PG8_SB(0, 1), b2 + hstep, voffB);
            PG8_WAIT_V(6); PG8_BAR; PG8_MMA(1, 1, At, B1); PG8_BAR;
            PG8_LDB(B0, 1, 0); PG8_SCHED; PG8_LDA(At, 1, 0); PG8_STAGE(PG8_SA(0, 1), a2 + hstep, voffA);
            PG8_WAIT_L(8); PG8_BAR; PG8_WAIT_L(0); PG8_MMA(0, 0, At, B0); PG8_BAR; PG8_SCHED;
            PG8_LDB(B1, 1, 1); PG8_STAGE(PG8_SB(1, 0), b3, voffB);
            PG8_BAR; PG8_WAIT_L(0); PG8_MMA(0, 1, At, B1); PG8_BAR;
            PG8_LDA(At, 1, 1); PG8_STAGE(PG8_SA(1, 0), a3, voffA);
            PG8_BAR; PG8_WAIT_L(0); PG8_MMA(1, 0, At, B0); PG8_BAR; PG8_SCHED;
            PG8_STAGE(PG8_SB(1, 1), b3 + hstep, voffB);
            PG8_WAIT_V(6); PG8_BAR; PG8_MMA(1, 1, At, B1); PG8_BAR;
            }
        }
        if constexpr (ALIGN_EPI) { if (wr == 0) PG8_BAR; }
        { Unit eu = cur; asm volatile("" : "+v"(eu.pm), "+v"(eu.pn));
          unsigned ze_ = 0u; asm volatile("" : "+v"(ze_)); const int le_ = (int)__builtin_amdgcn_mbcnt_hi(~0u, __builtin_amdgcn_mbcnt_lo(~0u, ze_));
          E(acc, eu, wr, wc, le_ & 15, le_ >> 4); } S.done(cur);
        if (!has_next) break;
#pragma unroll
        for (int a = 0; a < 2; ++a)
#pragma unroll
            for (int b = 0; b < 2; ++b)
#pragma unroll
                for (int m = 0; m < 4; ++m)
#pragma unroll
                    for (int n = 0; n < 2; ++n) acc[a][b][m][n] = (f32x4){0.f, 0.f, 0.f, 0.f};
        cur = nxt; cA = nA; cB = nB; ++ui;
        if constexpr (ALIGN_EPI) { if (wr == 1) PG8_BAR; }
    }
    PG8_WAIT_V(0);
    if constexpr (!ALIGN_EPI) { if (wr == 0) PG8_BAR; }
    PG8_BAR;
#undef PG8_SA
#undef PG8_SB
#undef PG8_STAGE
#undef PG8_STAGE_A
#undef PG8_LDA
#undef PG8_LDB
#undef PG8_MMA
#undef PG8_CAT
#undef PG8_WAIT_V
#undef PG8_WAIT_L
#undef PG8_BAR
#undef PG8_SCHED
}

typedef const f32x4 (&AccRef)[2][2][4][2];
__device__ __forceinline__ u32x4 pack8(const f32x4 a, const f32x4 b) { u32x4 w; w.x = cvt_pk_bf16(a[0], a[1]); w.y = cvt_pk_bf16(a[2], a[3]); w.z = cvt_pk_bf16(b[0], b[1]); w.w = cvt_pk_bf16(b[2], b[3]); return w; }
__device__ __forceinline__ void unpack8(const u32x4 w, f32x4& a, f32x4& b) {
    a[0] = __uint_as_float(w.x << 16); a[1] = __uint_as_float(w.x & 0xffff0000u); a[2] = __uint_as_float(w.y << 16); a[3] = __uint_as_float(w.y & 0xffff0000u);
    b[0] = __uint_as_float(w.z << 16); b[1] = __uint_as_float(w.z & 0xffff0000u); b[2] = __uint_as_float(w.w << 16); b[3] = __uint_as_float(w.w & 0xffff0000u); }
__device__ __forceinline__ f32x4 sig4(const f32x4 x) { f32x4 r; for (int j = 0; j < 4; ++j) r[j] = sigmoidf_(x[j]); return r; }

struct EpiWin {
    static constexpr bool PERM = true, AFTER_DRAIN = false;
    bf16_t* proj; float* dt; int pn_off, pad;
    __device__ __forceinline__ void operator()(AccRef acc, const Unit& u0, int wr, int wc, int fr, int fq) const {
        Unit u = u0; u.pn = u0.pn + pn_off;
        const int row0 = u.pm * BM + wr * 64 + fr;
        if (u.pn < 31) { const int col0 = u.pn * BM + wc * 32 + 8 * fq;
#pragma unroll
            for (int ai = 0; ai < 2; ++ai)
#pragma unroll
                for (int m = 0; m < 4; ++m) { bf16_t* rowp = proj + (size_t)(row0 + ai * HALF + m * 16) * NPROJ + col0;
#pragma unroll
                    for (int bj = 0; bj < 2; ++bj) *(u32x4*)(rowp + bj * HALF) = pack8(acc[ai][bj][m][0], acc[ai][bj][m][1]); }
        } else if (wc == 0) {
#pragma unroll
            for (int ai = 0; ai < 2; ++ai)
#pragma unroll
                for (int m = 0; m < 4; ++m) { float* rowp = dt + (size_t)(row0 + ai * HALF + m * 16) * 32 + 8 * fq;
                    *(f32x4*)rowp = acc[ai][0][m][0]; *(f32x4*)(rowp + 4) = acc[ai][0][m][1]; }
        }
    }
};
struct EpiGate {
    static constexpr bool PERM = true, AFTER_DRAIN = false;
    unsigned char* g8; const float* bg;
    __device__ __forceinline__ void operator()(AccRef acc, const Unit& u, int wr, int wc, int fr, int fq) const {
        const int row0 = u.pm * BM + wr * 64 + fr, col0 = u.pn * BM + wc * 32 + 8 * fq;
#pragma unroll
        for (int bj = 0; bj < 2; ++bj) { const f32x4 b0 = *(const f32x4*)(bg + col0 + bj * HALF), b1 = *(const f32x4*)(bg + col0 + bj * HALF + 4);
#pragma unroll
            for (int ai = 0; ai < 2; ++ai)
#pragma unroll
                for (int m = 0; m < 4; ++m) { const f32x4 s0 = sig4(acc[ai][bj][m][0] + b0), s1 = sig4(acc[ai][bj][m][1] + b1); unsigned lo = 0u, hi = 0u;
#pragma unroll
                    for (int j = 0; j < 4; ++j) { lo |= (unsigned)(s0[j] * 255.f + 0.5f) << (8 * j); hi |= (unsigned)(s1[j] * 255.f + 0.5f) << (8 * j); }
                    *(uint2*)(g8 + (size_t)(row0 + ai * HALF + m * 16) * 3072 + col0 + bj * HALF) = uint2{lo, hi}; } }
    }
};
template <int PASS> struct EpiMerge {
    static constexpr bool PERM = true, AFTER_DRAIN = false;
    const unsigned char* gsrc; const float* bg; float* macc; bf16_t* mo; const float* ssq;
    __device__ __forceinline__ void operator()(AccRef acc, const Unit& u, int wr, int wc, int fr, int fq) const {
        const int row0 = u.pm * BM + wr * 64 + fr, col0 = u.pn * BM + wc * 32 + 8 * fq, lane = fq * 16 + fr;
#pragma unroll
        for (int ai = 0; ai < 2; ++ai)
#pragma unroll
            for (int mh = 0; mh < 2; ++mh) { float rs[2] = {1.f, 1.f};
                if (PASS == 0) {
                    f32x4 sv[2][2];
#pragma unroll
                    for (int m2 = 0; m2 < 2; ++m2) { const float* sp = ssq + (size_t)(row0 + ai * HALF + (2 * mh + m2) * 16) * 32 + 8 * fq; sv[m2][0] = *(const f32x4*)sp; sv[m2][1] = *(const f32x4*)(sp + 4); }
#pragma unroll
                    for (int m2 = 0; m2 < 2; ++m2) { float sm = ((sv[m2][0][0] + sv[m2][0][1]) + (sv[m2][0][2] + sv[m2][0][3])) + ((sv[m2][1][0] + sv[m2][1][1]) + (sv[m2][1][2] + sv[m2][1][3]));
                        sm += __int_as_float(__builtin_amdgcn_ds_bpermute((lane ^ 16) << 2, __float_as_int(sm))); sm += __int_as_float(__builtin_amdgcn_ds_bpermute((lane ^ 32) << 2, __float_as_int(sm)));
                        rs[m2] = __builtin_amdgcn_rsqf(sm * (1.f / 1024.f) + NORM_EPS); } }
#pragma unroll
                for (int bj = 0; bj < 2; ++bj) { const int col = col0 + bj * HALF; uint2 gv[2]; u32x4 mq[2]; bf16_t* mb = (bf16_t*)macc;
#pragma unroll
                    for (int m2 = 0; m2 < 2; ++m2) { const size_t row = (size_t)(row0 + ai * HALF + (2 * mh + m2) * 16); gv[m2] = *(const uint2*)(gsrc + row * 3072 + col);
                        if (PASS != 0) mq[m2] = *(const u32x4*)(mb + row * D + col); }
#pragma unroll
                    for (int m2 = 0; m2 < 2; ++m2) { const int m = 2 * mh + m2; const size_t row = (size_t)(row0 + ai * HALF + m * 16); f32x4 g0, g1;
#pragma unroll
                        for (int j = 0; j < 4; ++j) { g0[j] = (float)((gv[m2].x >> (8 * j)) & 0xffu) * (1.f / 255.f); g1[j] = (float)((gv[m2].y >> (8 * j)) & 0xffu) * (1.f / 255.f); }
                        f32x4 v0 = g0 * acc[ai][bj][m][0], v1 = g1 * acc[ai][bj][m][1];
                        if (PASS == 0) *(u32x4*)(mb + row * D + col) = pack8(v0 * rs[m2], v1 * rs[m2]);
                        else { f32x4 a0, a1; unpack8(mq[m2], a0, a1);
                            if (PASS == 1) *(u32x4*)(mb + row * D + col) = pack8(a0 + v0, a1 + v1);
                            else *(u32x4*)(mo + row * D + col) = pack8(v0 + a0, v1 + a1); } } } }
    }
};
struct EpiWout {
    static constexpr bool PERM = true, AFTER_DRAIN = false;
    float* xl; const float* modl; float scale; int pad;
    __device__ __forceinline__ void operator()(AccRef acc, const Unit& u, int wr, int wc, int fr, int fq) const {
        const int row0 = u.pm * BM + wr * 64 + fr, col0 = u.pn * BM + wc * 32 + 8 * fq;
        const int mr = u.pm < TL / BM ? u.pm / (S / BM) : NB; const float* g1 = modl + ((size_t)mr * 6 + 2) * D;
#pragma unroll
        for (int bj = 0; bj < 2; ++bj) { const f32x4 gg0 = *(const f32x4*)(g1 + col0 + bj * HALF) * scale, gg1 = *(const f32x4*)(g1 + col0 + bj * HALF + 4) * scale;
#pragma unroll
            for (int ai = 0; ai < 2; ++ai)
#pragma unroll
                for (int mh = 0; mh < 2; ++mh) { const int col = col0 + bj * HALF; f32x4 xv[2][2];
#pragma unroll
                    for (int m2 = 0; m2 < 2; ++m2) { const bf16_t* xp = (const bf16_t*)xl + (size_t)(row0 + ai * HALF + (2 * mh + m2) * 16) * D + col; unpack8(*(const u32x4*)xp, xv[m2][0], xv[m2][1]); }
#pragma unroll
                    for (int m2 = 0; m2 < 2; ++m2) { const int m = 2 * mh + m2; bf16_t* xp = (bf16_t*)xl + (size_t)(row0 + ai * HALF + m * 16) * D + col;
                        *(u32x4*)xp = pack8(xv[m2][0] + gg0 * acc[ai][bj][m][0], xv[m2][1] + gg1 * acc[ai][bj][m][1]); } } }
    }
};
struct EpiMoe1 {
    static constexpr bool PERM = true, AFTER_DRAIN = false;
    bf16_t* act; const float* b1;
    __device__ __forceinline__ void operator()(AccRef acc, const Unit& u, int wr, int wc, int fr, int fq) const {
        const int row0 = u.pm * BM + wr * 64 + fr, e = u.pn >> 3, j = u.pn & 7, col = j * 128 + wc * 32 + 8 * fq;
        const float* bp = b1 + (size_t)e * 2048 + col; const f32x4 bg0 = *(const f32x4*)bp, bg1 = *(const f32x4*)(bp + 4), bu0 = *(const f32x4*)(bp + 1024), bu1 = *(const f32x4*)(bp + 1028);
#pragma unroll
        for (int ai = 0; ai < 2; ++ai)
#pragma unroll
            for (int m = 0; m < 4; ++m) { const f32x4 g0 = acc[ai][0][m][0] + bg0, g1 = acc[ai][0][m][1] + bg1, u0 = acc[ai][1][m][0] + bu0, u1 = acc[ai][1][m][1] + bu1; f32x4 r0, r1;
#pragma unroll
                for (int q = 0; q < 4; ++q) { r0[q] = swiglu_(g0[q], u0[q]); r1[q] = swiglu_(g1[q], u1[q]); }
                *(u32x4*)(act + (size_t)(row0 + ai * HALF + m * 16) * D + col) = pack8(r0, r1); }
    }
};
struct EpiMoe1F8 {
    static constexpr bool PERM = true, AFTER_DRAIN = false, HOOK = false;
    unsigned char* act8; const float* b1;
    __device__ __forceinline__ void operator()(AccRef acc, const Unit& u, int wr, int wc, int fr, int fq) const {
        const int row0 = u.pm * BM + wr * 64 + fr, e = u.pn >> 3, j = u.pn & 7, col = j * 128 + wc * 32 + 8 * fq;
        const float* bp = b1 + (size_t)e * 2048 + col; const f32x4 bg0 = *(const f32x4*)bp, bg1 = *(const f32x4*)(bp + 4), bu0 = *(const f32x4*)(bp + 1024), bu1 = *(const f32x4*)(bp + 1028);
#pragma unroll
        for (int ai = 0; ai < 2; ++ai)
#pragma unroll
            for (int m = 0; m < 4; ++m) { const f32x4 g0 = acc[ai][0][m][0] + bg0, g1 = acc[ai][0][m][1] + bg1, u0 = acc[ai][1][m][0] + bu0, u1 = acc[ai][1][m][1] + bu1; f32x4 r0, r1;
#pragma unroll
                for (int q = 0; q < 4; ++q) { r0[q] = swiglu_(g0[q], u0[q]) * 4.f; r1[q] = swiglu_(g1[q], u1[q]) * 4.f; }
                int lo = __builtin_amdgcn_cvt_pk_fp8_f32(r0[0], r0[1], 0, false); lo = __builtin_amdgcn_cvt_pk_fp8_f32(r0[2], r0[3], lo, true);
                int hi = __builtin_amdgcn_cvt_pk_fp8_f32(r1[0], r1[1], 0, false); hi = __builtin_amdgcn_cvt_pk_fp8_f32(r1[2], r1[3], hi, true);
                *(uint2*)(act8 + (size_t)(row0 + ai * HALF + m * 16) * D + col) = uint2{(unsigned)lo, (unsigned)hi}; }
    }
};
struct EpiMoe2 {
    static constexpr bool PERM = true, AFTER_DRAIN = false;
    bf16_t* ys; const float* b2;
    __device__ __forceinline__ void operator()(AccRef acc, const Unit& u, int wr, int wc, int fr, int fq) const {
        const int row0 = u.pm * BM + wr * 64 + fr, e = u.pn >> 2, j = u.pn & 3, col0 = j * BM + wc * 32 + 8 * fq;
#pragma unroll
        for (int bj = 0; bj < 2; ++bj) { const int col = col0 + bj * HALF; const float* bp = b2 + (size_t)e * D + col; const f32x4 a0 = *(const f32x4*)bp, a1 = *(const f32x4*)(bp + 4);
#pragma unroll
            for (int ai = 0; ai < 2; ++ai)
#pragma unroll
                for (int m = 0; m < 4; ++m) *(u32x4*)(ys + (size_t)(row0 + ai * HALF + m * 16) * D + col) = pack8(acc[ai][bj][m][0] + a0, acc[ai][bj][m][1] + a1); }
    }
};
}

#define XB_TMO      128
#define XB_XCNT(j)  (256  + 64 * (j))
#define XB_XSUB(j)  (1280 + 64 * (j))
#define XB_XGEN(j)  (2304 + 64 * (j))
#define XB_TOP      3328
#define XB_TOPGEN   3392
#define XCD_BAR_WORDS 3456
#define XB_SPIN_CAP (1u << 18)
#define LAS __attribute__((address_space(3)))
__device__ __forceinline__ unsigned xb_ld(unsigned* p)              { return __hip_atomic_load(p, __ATOMIC_RELAXED, __HIP_MEMORY_SCOPE_AGENT); }
__device__ __forceinline__ unsigned xb_add(unsigned* p, unsigned v) { return __hip_atomic_fetch_add(p, v, __ATOMIC_RELAXED, __HIP_MEMORY_SCOPE_AGENT); }
__device__ __forceinline__ unsigned xb_xcc_id() { return (unsigned)__builtin_amdgcn_s_getreg((3 << 11) | 20) & 0xFu; }
#define XB_SPIN(cond, bar) do { unsigned _sp = 0; while (cond) { __builtin_amdgcn_s_sleep(1); \
    if ((++_sp & 255u) == 0u) { if (xb_ld(&(bar)[XB_TMO])) break; if (_sp > XB_SPIN_CAP) { atomicAdd(&(bar)[XB_TMO], 1u); break; } } } } while (0)
struct XcdBarrier { unsigned* bar; unsigned x; volatile LAS unsigned* st; };
__device__ __forceinline__ XcdBarrier xcd_barrier_post(unsigned* bar, volatile LAS unsigned* st) {
    XcdBarrier b; b.bar = bar; b.x = xb_xcc_id(); b.st = st;
    if (threadIdx.x == 0) (void)xb_add(&bar[XB_XCNT(b.x)], 1u);
    return b;
}
__device__ __forceinline__ void xcd_barrier_complete(unsigned* bar, unsigned x, unsigned& nloc, unsigned& nx) {
    const unsigned G = gridDim.x * gridDim.y * gridDim.z;
    unsigned sum, cnt, mine, sp = 0u;
    for (;;) {
        sum = 0u; cnt = 0u; mine = 0u;
#pragma unroll
        for (unsigned j = 0; j < 16; ++j) { const unsigned c = xb_ld(&bar[XB_XCNT(j)]); sum += c; cnt += (c > 0u) ? 1u : 0u; mine = (j == x) ? c : mine; }
        if (sum == G) break;
        __builtin_amdgcn_s_sleep(1);
        if ((++sp & 255u) == 0u) { if (xb_ld(&bar[XB_TMO])) break; if (sp > XB_SPIN_CAP) { atomicAdd(&bar[XB_TMO], 1u); break; } }
    }
    nloc = mine > 0u ? mine : 1u; nx = cnt > 0u ? cnt : 1u;
}
__device__ __noinline__ void xcd_barrier_impl(unsigned* bar_, unsigned x_, unsigned st_off, unsigned is_leader) {
    XcdBarrier b; b.bar = bar_; b.x = x_; b.st = (volatile LAS unsigned*)st_off;
    asm volatile("s_waitcnt vmcnt(0)" ::: "memory");
    __syncthreads();
    if (is_leader) {
        unsigned* bar = b.bar;
        __builtin_amdgcn_s_waitcnt(0);
        unsigned nloc = b.st[0], nx = b.st[1];
        if (nloc == 0u) { xcd_barrier_complete(bar, b.x, nloc, nx); b.st[0] = nloc; b.st[1] = nx; }
        const unsigned old = xb_add(&bar[XB_XSUB(b.x)], 1u);
        const unsigned gen = old / nloc;
        if (old + 1u == (gen + 1u) * nloc) {
            __builtin_amdgcn_fence(__ATOMIC_RELEASE, "agent");
            asm volatile("s_waitcnt vmcnt(0)" ::: "memory");
            const unsigned og = xb_add(&bar[XB_TOP], 1u);
            const unsigned tg = og / nx;
            if (og + 1u == (tg + 1u) * nx) xb_add(&bar[XB_TOPGEN], 1u);
            else XB_SPIN(xb_ld(&bar[XB_TOPGEN]) == tg, bar);
            __builtin_amdgcn_fence(__ATOMIC_ACQUIRE, "agent");
            xb_add(&bar[XB_XGEN(b.x)], 1u);
            asm volatile("s_waitcnt vmcnt(0)" ::: "memory");
        } else {
            XB_SPIN(xb_ld(&bar[XB_XGEN(b.x)]) == gen, bar);
            __builtin_amdgcn_fence(__ATOMIC_ACQUIRE, "agent");
            asm volatile("s_waitcnt vmcnt(0)" ::: "memory");
        }
    }
    __syncthreads();
}
__device__ __forceinline__ void xcd_barrier(const XcdBarrier& b, unsigned is_leader) { xcd_barrier_impl(b.bar, b.x, (unsigned)(unsigned long)b.st, is_leader); }

#ifndef CAPM_PCT
#define CAPM_PCT 90
#endif
#ifndef CAPW_PCT
#define CAPW_PCT 41
#endif
constexpr int NTHR = 512;
constexpr int LDS_MAIN = 131072, LDS_CTL_OFF = LDS_MAIN, LDS_BYTES = 147456;
struct TDesc { const float* src; bf16* dst; int K, Nsrc, Ndst, map, fp8; };
__device__ __forceinline__ void transpose_item(const TDesc& t, LAS unsigned short* img, int item, int lane) {
    const int nblk = t.Ndst / 64, kb = item / nblk, nb = item % nblk, k0 = 64 * kb, n0 = 64 * nb, c4 = (lane & 15) * 4, kq = lane >> 4;
    const int s0 = t.map == 1 ? win_src(n0 + c4) : (t.map == 2 ? w1_src(n0 + c4) : n0 + c4);
    float4 v[16];
#pragma unroll
    for (int i = 0; i < 16; ++i) v[i] = s0 >= 0 ? *(const float4*)(t.src + (size_t)(k0 + 4 * i + kq) * t.Nsrc + s0) : float4{0.f, 0.f, 0.f, 0.f};
    if (t.fp8) {
        LAS unsigned char* im8 = (LAS unsigned char*)img;
#pragma unroll
        for (int i = 0; i < 16; ++i) { const int a = __builtin_amdgcn_cvt_pk_fp8_f32(v[i].x * 32.f, v[i].y * 32.f, 0, false), b = __builtin_amdgcn_cvt_pk_fp8_f32(v[i].z * 32.f, v[i].w * 32.f, 0, false);
            LAS unsigned char* o = im8 + c4 * 68 + 4 * i + kq; o[0] = (unsigned char)a; o[68] = (unsigned char)(a >> 8); o[136] = (unsigned char)b; o[204] = (unsigned char)(b >> 8); }
        asm volatile("s_waitcnt lgkmcnt(0)" ::: "memory");
        const int c = lane & 3;
#pragma unroll
        for (int j = 0; j < 4; ++j) { const int n = (lane >> 2) + 16 * j; const LAS unsigned* r = (const LAS unsigned*)(im8 + n * 68 + 16 * c);
            uint4 o; o.x = r[0]; o.y = r[1]; o.z = r[2]; o.w = r[3];
            *(uint4*)((unsigned char*)t.dst + (size_t)(n0 + n) * t.K + k0 + 16 * c) = o; }
        asm volatile("s_waitcnt lgkmcnt(0)" ::: "memory");
        return; }
#pragma unroll
    for (int i = 0; i < 16; ++i) { LAS unsigned short* o = img + c4 * 66 + 4 * i + kq; o[0] = f2bf(v[i].x); o[66] = f2bf(v[i].y); o[132] = f2bf(v[i].z); o[198] = f2bf(v[i].w); }
    asm volatile("s_waitcnt lgkmcnt(0)" ::: "memory");
    const int c = lane & 7;
#pragma unroll
    for (int j = 0; j < 8; ++j) { const int n = (lane >> 3) + 8 * j; const LAS unsigned* r = (const LAS unsigned*)(img + n * 66 + 8 * c);
        uint4 o; o.x = r[0]; o.y = r[1]; o.z = r[2]; o.w = r[3];
        *(uint4*)(t.dst + (size_t)(n0 + n) * t.K + k0 + 8 * c) = o; }
    asm volatile("s_waitcnt lgkmcnt(0)" ::: "memory");
}
constexpr int TI_WIN = 16 * 128, TI_SQ = 16 * 16, TI_HALF = 8 * 16, TI_W1 = 16 * 32, TI_LAYER = TI_WIN + TI_SQ + 2 * TI_HALF + TI_SQ + NE * TI_W1 + NE * TI_SQ;
constexpr int TI_NONMOE_G = TI_WIN + TI_SQ + 2 * TI_HALF + TI_SQ;
constexpr int GEMM_WG = 144;
constexpr long TI_ALL = (long)NL * TI_LAYER, CAP_M = (long)TI_LAYER * CAPM_PCT / 100, CAP_W = (long)TI_LAYER * CAPW_PCT / 100;
constexpr long SCH_P0 = TI_ALL - (NL - 1) * (CAP_M + CAP_W) > TI_NONMOE_G ? TI_ALL - (NL - 1) * (CAP_M + CAP_W) : TI_NONMOE_G;
constexpr long sch_merge_lo(int l) { return SCH_P0 + l * (CAP_M + CAP_W) < TI_ALL ? SCH_P0 + l * (CAP_M + CAP_W) : TI_ALL; }
constexpr long sch_wout_lo(int l) { return sch_merge_lo(l) + CAP_M < TI_ALL ? sch_merge_lo(l) + CAP_M : TI_ALL; }
constexpr long sch_wout_hi(int l) { return l == NL - 2 ? TI_ALL : sch_merge_lo(l + 1); }
constexpr bool sch_ok() { for (int l = 0; l + 1 < NL; ++l) { if (sch_wout_hi(l) < (long)(l + 1) * TI_LAYER + TI_NONMOE_G && sch_wout_hi(l) < TI_ALL) return false; if (sch_wout_hi(l) < (long)(l + 1) * TI_LAYER) return false; } return SCH_P0 >= TI_NONMOE_G; }
static_assert(NL < 2 || sch_ok(), "conversion schedule misses a deadline");

__device__ __forceinline__ float xshf(float v, int o, int lane) { return __int_as_float(__builtin_amdgcn_ds_bpermute((lane ^ o) << 2, __float_as_int(v))); }
__device__ __forceinline__ int xshi(int v, int o, int lane) { return __builtin_amdgcn_ds_bpermute((lane ^ o) << 2, v); }
__device__ __forceinline__ float wave_sum(float v, int lane) {
#pragma unroll
    for (int o = 1; o < 64; o <<= 1) v += xshf(v, o, lane);
    return v; }
__device__ __forceinline__ float4 bf4(const uint2 u) { float4 r; r.x = u2f(u.x << 16); r.y = u2f(u.x & 0xffff0000u); r.z = u2f(u.y << 16); r.w = u2f(u.y & 0xffff0000u); return r; }
__device__ __forceinline__ uint2 pk4(const float4 v) { uint2 r; r.x = pk2(v.x, v.y); r.y = pk2(v.z, v.w); return r; }
__device__ __forceinline__ float4 f4mad(const float4 a, const float4 b, const float4 c) { return float4{a.x * b.x + c.x, a.y * b.y + c.y, a.z * b.z + c.z, a.w * b.w + c.w}; }
__device__ __forceinline__ float f4sq(const float4 a) { return (a.x * a.x + a.y * a.y) + (a.z * a.z + a.w * a.w); }

__device__ __forceinline__ void dev_combine(const P& p, int lp, int r, int lane, float4 (&v)[4]) {
    const float* g2 = mod_ptr(p, lp, r, 5); const int* so = slot_of_(p) + r * 4; const float* tw = topw_(p) + r * 4;
    const int q0 = so[0], q1 = so[1], q2 = so[2], q3 = so[3]; const float w0 = tw[0], w1 = tw[1], w2 = tw[2], w3 = tw[3];
    const int s0 = pstart_(p)[q0 >> 20] + (q0 & 0xfffff), s1 = pstart_(p)[q1 >> 20] + (q1 & 0xfffff), s2 = pstart_(p)[q2 >> 20] + (q2 & 0xfffff), s3 = pstart_(p)[q3 >> 20] + (q3 & 0xfffff);
#pragma unroll
    for (int j = 0; j < 4; ++j) { const int idx = (j * 64 + lane) * 4;
        const float4 a = bf4(*(const uint2*)(ys_(p) + (size_t)s0 * D + idx)), b = bf4(*(const uint2*)(ys_(p) + (size_t)s1 * D + idx)), c = bf4(*(const uint2*)(ys_(p) + (size_t)s2 * D + idx)), d = bf4(*(const uint2*)(ys_(p) + (size_t)s3 * D + idx));
        const float4 g = *(const float4*)(g2 + idx);
        v[j].x += g.x * (((w0 * a.x + w1 * b.x) + w2 * c.x) + w3 * d.x); v[j].y += g.y * (((w0 * a.y + w1 * b.y) + w2 * c.y) + w3 * d.y);
        v[j].z += g.z * (((w0 * a.z + w1 * b.z) + w2 * c.z) + w3 * d.z); v[j].w += g.w * (((w0 * a.w + w1 * b.w) + w2 * c.w) + w3 * d.w); } }


namespace att {
typedef short bf16x8 __attribute__((ext_vector_type(8)));
typedef float f32x16 __attribute__((ext_vector_type(16)));
typedef unsigned u32x2 __attribute__((ext_vector_type(2)));
typedef unsigned u32x4 __attribute__((ext_vector_type(4)));
constexpr int VT_RS = 72;
constexpr float LOG2E = 1.4426950408889634f, C2 = 0.125f * LOG2E;
struct State { f32x16 o0, o1; float m, l; };
__device__ __forceinline__ int crow(int r, int hi) { return (r & 3) + 8 * (r >> 2) + 4 * hi; }
__device__ __forceinline__ void load_q(bf16x8 (&qf)[4], const bf16* qp, int qstride, int lane) {
#pragma unroll
    for (int ks = 0; ks < 4; ++ks) qf[ks] = *(const bf16x8*)(qp + (size_t)(lane & 31) * qstride + 16 * ks + 8 * (lane >> 5)); }
__device__ __forceinline__ void load_q_at(bf16x8 (&qf)[4], const bf16* rowp, int lane) {
#pragma unroll
    for (int ks = 0; ks < 4; ++ks) qf[ks] = *(const bf16x8*)(rowp + 16 * ks + 8 * (lane >> 5)); }
struct KV { bf16x8 kf[4]; u32x4 vv[4]; };
__device__ __forceinline__ void load_kv(KV& kv, const bf16* kp, int kstride, const bf16* vp, int vstride, int lane) {
    const int r32 = lane & 31, hi = lane >> 5, quad = lane >> 3, chunk = lane & 7;
#pragma unroll
    for (int ks = 0; ks < 4; ++ks) kv.kf[ks] = *(const bf16x8*)(kp + (size_t)r32 * kstride + 16 * ks + 8 * hi);
#pragma unroll
    for (int i = 0; i < 4; ++i) kv.vv[i] = *(const u32x4*)(vp + (size_t)(4 * quad + i) * vstride + 8 * chunk);
}
template <class MaskF>
__device__ __forceinline__ void compute(State& st, const bf16x8 (&qf)[4], const KV& kv, LAS unsigned char* vt, int lane, MaskF maskf) {
    const int r32 = lane & 31, hi = lane >> 5, quad = lane >> 3, chunk = lane & 7;
#pragma unroll
    for (int dd = 0; dd < 8; ++dd) { const unsigned sel = (dd & 1) ? 0x07060302u : 0x05040100u; u32x2 w;
        w.x = __builtin_amdgcn_perm(kv.vv[1][dd >> 1], kv.vv[0][dd >> 1], sel); w.y = __builtin_amdgcn_perm(kv.vv[3][dd >> 1], kv.vv[2][dd >> 1], sel);
        *(LAS u32x2*)(vt + (8 * chunk + dd) * VT_RS + quad * 8) = w; }
    f32x16 sc, sc2;
#pragma unroll
    for (int r = 0; r < 16; ++r) { sc[r] = 0.f; sc2[r] = 0.f; }
    sc = __builtin_amdgcn_mfma_f32_32x32x16_bf16(kv.kf[0], qf[0], sc, 0, 0, 0); sc2 = __builtin_amdgcn_mfma_f32_32x32x16_bf16(kv.kf[1], qf[1], sc2, 0, 0, 0);
    sc = __builtin_amdgcn_mfma_f32_32x32x16_bf16(kv.kf[2], qf[2], sc, 0, 0, 0); sc2 = __builtin_amdgcn_mfma_f32_32x32x16_bf16(kv.kf[3], qf[3], sc2, 0, 0, 0);
#pragma unroll
    for (int r = 0; r < 16; ++r) sc[r] += sc2[r];
    float mx = -INFINITY;
#pragma unroll
    for (int r = 0; r < 16; ++r) { sc[r] = maskf(r, sc[r]); mx = fmaxf(mx, sc[r]); }
    { const auto sw = __builtin_amdgcn_permlane32_swap(__float_as_uint(mx), __float_as_uint(mx), false, false); mx = fmaxf(__uint_as_float(sw[0]), __uint_as_float(sw[1])); }
    const float mn = fmaxf(st.m, mx * C2);
    if (__builtin_amdgcn_ballot_w64(mn != st.m)) {
        const float alpha = __builtin_amdgcn_exp2f(st.m - mn); st.l *= alpha;
#pragma unroll
        for (int r = 0; r < 16; ++r) { st.o0[r] *= alpha; st.o1[r] *= alpha; }
        st.m = mn; }
    float rs = 0.f;
#pragma unroll
    for (int r = 0; r < 16; ++r) { sc[r] = __builtin_amdgcn_exp2f(__builtin_fmaf(sc[r], C2, -mn)); rs += sc[r]; }
    st.l += rs;
    bf16x8 pb[2];
#pragma unroll
    for (int s2 = 0; s2 < 2; ++s2) { u32x4 w;
        w.x = pg8::cvt_pk_bf16(sc[8 * s2 + 0], sc[8 * s2 + 1]); w.y = pg8::cvt_pk_bf16(sc[8 * s2 + 2], sc[8 * s2 + 3]); w.z = pg8::cvt_pk_bf16(sc[8 * s2 + 4], sc[8 * s2 + 5]); w.w = pg8::cvt_pk_bf16(sc[8 * s2 + 6], sc[8 * s2 + 7]);
        pb[s2] = __builtin_bit_cast(bf16x8, w); }
    asm volatile("s_waitcnt lgkmcnt(0)" ::: "memory");
#pragma unroll
    for (int s2 = 0; s2 < 2; ++s2) {
        const LAS unsigned char* a0 = vt + r32 * VT_RS + (16 * s2 + 4 * hi) * 2;
        u32x4 w0, w1; { const u32x2 x = *(const LAS u32x2*)a0, y = *(const LAS u32x2*)(a0 + 16); w0 = u32x4{x.x, x.y, y.x, y.y}; }
        { const u32x2 x = *(const LAS u32x2*)(a0 + 32 * VT_RS), y = *(const LAS u32x2*)(a0 + 32 * VT_RS + 16); w1 = u32x4{x.x, x.y, y.x, y.y}; }
        st.o0 = __builtin_amdgcn_mfma_f32_32x32x16_bf16(__builtin_bit_cast(bf16x8, w0), pb[s2], st.o0, 0, 0, 0);
        st.o1 = __builtin_amdgcn_mfma_f32_32x32x16_bf16(__builtin_bit_cast(bf16x8, w1), pb[s2], st.o1, 0, 0, 0); }
    asm volatile("s_waitcnt lgkmcnt(0)" ::: "memory");
}
template <class PtrF, class CompF>
__device__ __forceinline__ void run(int n, PtrF ptrf, CompF compf, int lane) {
    KV cur, nxt; { const bf16* kp; const bf16* vp; int ks, vs; ptrf(0, kp, ks, vp, vs); load_kv(cur, kp, ks, vp, vs, lane); }
#pragma unroll 1
    for (int i = 0; i < n; ++i) {
        if (i + 1 < n) { const bf16* kp; const bf16* vp; int ks, vs; ptrf(i + 1, kp, ks, vp, vs); load_kv(nxt, kp, ks, vp, vs, lane); }
        compf(i, cur);
        cur = nxt; }
}
__device__ __forceinline__ void init(State& st, float m0, float l0) {
#pragma unroll
    for (int r = 0; r < 16; ++r) { st.o0[r] = 0.f; st.o1[r] = 0.f; }
    st.m = m0; st.l = l0; }
__device__ __forceinline__ void finish(State& st, bf16* op, int ostride, int lane) {
    const float lt = st.l + xshf(st.l, 32, lane), inv = 1.f / lt; bf16* row = op + (size_t)(lane & 31) * ostride + 4 * (lane >> 5);
#pragma unroll
    for (int g = 0; g < 4; ++g) { u32x2 a, b;
        a.x = pg8::cvt_pk_bf16(st.o0[4 * g] * inv, st.o0[4 * g + 1] * inv); a.y = pg8::cvt_pk_bf16(st.o0[4 * g + 2] * inv, st.o0[4 * g + 3] * inv);
        b.x = pg8::cvt_pk_bf16(st.o1[4 * g] * inv, st.o1[4 * g + 1] * inv); b.y = pg8::cvt_pk_bf16(st.o1[4 * g + 2] * inv, st.o1[4 * g + 3] * inv);
        *(u32x2*)(row + 8 * g) = a; *(u32x2*)(row + 32 + 8 * g) = b; } }
__device__ __forceinline__ void finish_at(State& st, bf16* rowp, int lane) {
    const float lt = st.l + xshf(st.l, 32, lane), inv = 1.f / lt; bf16* row = rowp + 4 * (lane >> 5);
#pragma unroll
    for (int g = 0; g < 4; ++g) { u32x2 a, b;
        a.x = pg8::cvt_pk_bf16(st.o0[4 * g] * inv, st.o0[4 * g + 1] * inv); a.y = pg8::cvt_pk_bf16(st.o0[4 * g + 2] * inv, st.o0[4 * g + 3] * inv);
        b.x = pg8::cvt_pk_bf16(st.o1[4 * g] * inv, st.o1[4 * g + 1] * inv); b.y = pg8::cvt_pk_bf16(st.o1[4 * g + 2] * inv, st.o1[4 * g + 3] * inv);
        *(u32x2*)(row + 8 * g) = a; *(u32x2*)(row + 32 + 8 * g) = b; } }
struct NoMask { __device__ __forceinline__ float operator()(int, float s) const { return s; } };

constexpr int KRS = 144, KMAX = 384, VRS = KMAX * 2 + 24, LB_K = 0, LB_V = KMAX * KRS, LB_RPB = LB_V + 64 * VRS;
static_assert(LB_RPB + 2048 <= 131072, "attention batch LDS map");
template <class PtrF>
__device__ __forceinline__ void stage_batch(LAS unsigned char* lds, int ntiles, PtrF ptrf, unsigned t) {
    u32x4 kreg[6], vreg[2][4]; const int nk = ntiles * 256 - 1, nv = ntiles * 64 - 1;
#pragma unroll
    for (int i = 0; i < 6; ++i) { int id = t + 512 * i; id = id < nk ? id : nk; const int tl = id >> 8, row = (id & 255) >> 3, ch = id & 7; const bf16* kp; const bf16* vp; int ks, vs; ptrf(tl, kp, ks, vp, vs);
        kreg[i] = *(const u32x4*)(kp + (size_t)row * ks + ch * 8); }
#pragma unroll
    for (int j = 0; j < 2; ++j) { int id = t + 512 * j; id = id < nv ? id : nv; const int tl = id >> 6, quad = id & 7, chunk = (id & 63) >> 3; const bf16* kp; const bf16* vp; int ks, vs; ptrf(tl, kp, ks, vp, vs);
#pragma unroll
        for (int q = 0; q < 4; ++q) vreg[j][q] = *(const u32x4*)(vp + (size_t)(4 * quad + q) * vs + 8 * chunk); }
#pragma unroll
    for (int i = 0; i < 6; ++i) { const int id = t + 512 * i; if (id <= nk) { const int tl = id >> 8, row = (id & 255) >> 3, ch = id & 7; *(LAS u32x4*)(lds + LB_K + (tl * 32 + row) * KRS + ch * 16) = kreg[i]; } }
#pragma unroll
    for (int j = 0; j < 2; ++j) { const int id = t + 512 * j; if (id <= nv) { const int tl = id >> 6, quad = id & 7, chunk = (id & 63) >> 3;
#pragma unroll
            for (int dd = 0; dd < 8; ++dd) { const unsigned sel = (dd & 1) ? 0x07060302u : 0x05040100u; u32x2 w;
                w.x = __builtin_amdgcn_perm(vreg[j][1][dd >> 1], vreg[j][0][dd >> 1], sel); w.y = __builtin_amdgcn_perm(vreg[j][3][dd >> 1], vreg[j][2][dd >> 1], sel);
                *(LAS u32x2*)(lds + LB_V + (8 * chunk + dd) * VRS + (tl * 32 + 4 * quad) * 2) = w; } } }
}
template <class MaskF>
__device__ __forceinline__ void compute_lds(State& st, const bf16x8 (&qf)[4], const LAS unsigned char* lds, int koff, int lane, MaskF maskf) {
    const int r32 = lane & 31, hi = lane >> 5;
    f32x16 sc;
#pragma unroll
    for (int r = 0; r < 16; ++r) sc[r] = 0.f;
#pragma unroll
    for (int ks = 0; ks < 4; ++ks) { const bf16x8 kf = *(const LAS bf16x8*)(lds + LB_K + (koff + r32) * KRS + (2 * ks + hi) * 16); sc = __builtin_amdgcn_mfma_f32_32x32x16_bf16(kf, qf[ks], sc, 0, 0, 0); }
    float mx = -INFINITY;
#pragma unroll
    for (int r = 0; r < 16; ++r) { sc[r] = maskf(r, sc[r]); mx = fmaxf(mx, sc[r]); }
    { const auto sw = __builtin_amdgcn_permlane32_swap(__float_as_uint(mx), __float_as_uint(mx), false, false); mx = fmaxf(__uint_as_float(sw[0]), __uint_as_float(sw[1])); }
    const float mn = fmaxf(st.m, mx * C2);
    if (__builtin_amdgcn_ballot_w64(mn != st.m)) {
        const float alpha = __builtin_amdgcn_exp2f(st.m - mn); st.l *= alpha;
#pragma unroll
        for (int r = 0; r < 16; ++r) { st.o0[r] *= alpha; st.o1[r] *= alpha; }
        st.m = mn; }
    float rs = 0.f;
#pragma unroll
    for (int r = 0; r < 16; ++r) { sc[r] = __builtin_amdgcn_exp2f(__builtin_fmaf(sc[r], C2, -mn)); rs += sc[r]; }
    st.l += rs;
#pragma unroll
    for (int s2 = 0; s2 < 2; ++s2) { u32x4 w;
        w.x = pg8::cvt_pk_bf16(sc[8 * s2 + 0], sc[8 * s2 + 1]); w.y = pg8::cvt_pk_bf16(sc[8 * s2 + 2], sc[8 * s2 + 3]); w.z = pg8::cvt_pk_bf16(sc[8 * s2 + 4], sc[8 * s2 + 5]); w.w = pg8::cvt_pk_bf16(sc[8 * s2 + 6], sc[8 * s2 + 7]);
        const bf16x8 pb = __builtin_bit_cast(bf16x8, w);
        const LAS unsigned char* a0 = lds + LB_V + r32 * VRS + (koff + 16 * s2 + 4 * hi) * 2;
        u32x4 w0, w1; { const u32x2 x = *(const LAS u32x2*)a0, y = *(const LAS u32x2*)(a0 + 16); w0 = u32x4{x.x, x.y, y.x, y.y}; }
        { const u32x2 x = *(const LAS u32x2*)(a0 + 32 * VRS), y = *(const LAS u32x2*)(a0 + 32 * VRS + 16); w1 = u32x4{x.x, x.y, y.x, y.y}; }
        st.o0 = __builtin_amdgcn_mfma_f32_32x32x16_bf16(__builtin_bit_cast(bf16x8, w0), pb, st.o0, 0, 0, 0);
        st.o1 = __builtin_amdgcn_mfma_f32_32x32x16_bf16(__builtin_bit_cast(bf16x8, w1), pb, st.o1, 0, 0, 0); }
}
}


namespace ssd {
using att::bf16x8; using att::f32x16; using att::u32x2; using att::u32x4; using att::crow; using att::LOG2E;
constexpr int XRS = 272;
constexpr int L_TAB = 0, L_XT0 = 2048, L_XT1 = L_XT0 + 64 * XRS, L_BT = L_XT1 + 64 * XRS;
__device__ __forceinline__ int chunk_row(int b, int c) { return c < 2 ? TL + b * LC + c * 128 : b * S + (c - 2) * 128; }
template <bool WITH_W> __device__ __forceinline__ void tab_compute(const P& p, int l, int row0, int hh, int dir, int lane, LAS float* tab, LAS float* wtab) {
    {
        const float A = -fexp_(a_log_(p)[(l * 2 + dir) * 16 + hh]) * LOG2E, bias = dt_bias_(p)[(l * 2 + dir) * 16 + hh];
        const float d0 = softplusf_(dt_(p)[(size_t)(row0 + 2 * lane) * 32 + dir * 16 + hh] + bias), d1 = softplusf_(dt_(p)[(size_t)(row0 + 2 * lane + 1) * 32 + dir * 16 + hh] + bias);
        const float a0 = d0 * A, a1 = d1 * A, sm = a0 + a1; float v = sm;
        if (dir == 0) {
#pragma unroll
            for (int o = 1; o < 64; o <<= 1) { const float u = __int_as_float(__builtin_amdgcn_ds_bpermute((lane - o) << 2, __float_as_int(v))); if (lane >= o) v += u; }
            const float ex = v - sm; tab[2 * lane] = ex + a0; tab[2 * lane + 1] = ex + sm;
        } else {
#pragma unroll
            for (int o = 1; o < 64; o <<= 1) { const float u = __int_as_float(__builtin_amdgcn_ds_bpermute((lane + o) << 2, __float_as_int(v))); if (lane + o < 64) v += u; }
            const float ex = v - sm; tab[128 + 2 * lane + 1] = ex + a1; tab[128 + 2 * lane] = ex + sm;
        }
        tab[256 + dir * 128 + 2 * lane] = d0; tab[256 + dir * 128 + 2 * lane + 1] = d1;
        if constexpr (WITH_W) {
#pragma unroll
            for (int ti = 0; ti < 4; ++ti)
#pragma unroll
                for (int j = 0; j < 2; ++j) { const int sidx = lane + 64 * j;
                    if (dir == 0) { if (ti > 0 && sidx < 32 * ti) wtab[ti * 128 + sidx] = __builtin_amdgcn_exp2f(tab[32 * ti - 1] - tab[sidx]) * tab[256 + sidx]; }
                    else { if (ti < 3 && sidx >= 32 * (ti + 1)) wtab[512 + ti * 128 + sidx] = __builtin_amdgcn_exp2f(tab[128 + 32 * (ti + 1)] - tab[128 + sidx]) * tab[384 + sidx]; } } }
    }
}
template <class ScaleF>
__device__ __forceinline__ void stage_T(const bf16* src, int stride, LAS unsigned char* img, int quad, int chunk, ScaleF sc) {
    u32x4 vv[4];
#pragma unroll
    for (int i = 0; i < 4; ++i) vv[i] = *(const u32x4*)(src + (size_t)(4 * quad + i) * stride + 8 * chunk);
    float w[4];
#pragma unroll
    for (int i = 0; i < 4; ++i) w[i] = sc(4 * quad + i);
#pragma unroll
    for (int dd = 0; dd < 8; ++dd) { float f[4];
#pragma unroll
        for (int i = 0; i < 4; ++i) { const unsigned wd = vv[i][dd >> 1]; f[i] = u2f((dd & 1) ? (wd & 0xffff0000u) : (wd << 16)) * w[i]; }
        u32x2 o; o.x = pg8::cvt_pk_bf16(f[0], f[1]); o.y = pg8::cvt_pk_bf16(f[2], f[3]);
        *(LAS u32x2*)(img + (8 * chunk + dd) * XRS + quad * 8) = o; }
}
template <class ScaleF>
__device__ __forceinline__ void stage_T_regs(const u32x4 (&vv)[4], LAS unsigned char* img, int quad, int chunk, ScaleF sc) {
    float w[4];
#pragma unroll
    for (int i = 0; i < 4; ++i) w[i] = sc(4 * quad + i);
#pragma unroll
    for (int dd = 0; dd < 8; ++dd) { float f[4];
#pragma unroll
        for (int i = 0; i < 4; ++i) { const unsigned wd = vv[i][dd >> 1]; f[i] = u2f((dd & 1) ? (wd & 0xffff0000u) : (wd << 16)) * w[i]; }
        u32x2 o; o.x = pg8::cvt_pk_bf16(f[0], f[1]); o.y = pg8::cvt_pk_bf16(f[2], f[3]);
        *(LAS u32x2*)(img + (8 * chunk + dd) * XRS + quad * 8) = o; }
}
}

struct MegaEx {
    LAS unsigned char* lds; XcdBarrier bar;
    __device__ __forceinline__ void sync() { xcd_barrier(bar, tid_() == 0u ? 1u : 0u); }
    int wid;
    __device__ __forceinline__ unsigned tid_() { unsigned z = 0u; asm volatile("" : "+v"(z)); const unsigned ln = __builtin_amdgcn_mbcnt_hi(~0u, __builtin_amdgcn_mbcnt_lo(~0u, z)); unsigned r = (unsigned)wid * 64u + ln; asm volatile("" : "+v"(r)); return r; }
    __device__ __forceinline__ int ssd_unit(int k) const { const int bx = (int)blockIdx.x; return gridDim.x == 256 ? k * 256 + (bx & 7) * 32 + (bx >> 3) : k * (int)gridDim.x + bx; }
    template <class F> __device__ __forceinline__ void items_ns(long n, F f) { const unsigned t = tid_(); for (long i = (long)blockIdx.x * NTHR + t; i < n; i += (long)gridDim.x * NTHR) f(i); }
    template <class F> __device__ __forceinline__ void items(long n, F f) { items_ns(n, f); sync(); }
    template <class Epi> __device__ __forceinline__ void gs(const bf16* A, const bf16* Bt, int M, int N, int K, const Epi& E, int G = 0) {
        pg8::Gemm g{A, Bt, M, N, K, 0}; pg8::StaticOrder S; S.init(M, N, G > 0 ? G : (int)gridDim.x, (int)blockIdx.x);
        if (G > 0 && (int)blockIdx.x >= G) return;
        pg8::gemm_phase<Epi, pg8::StaticOrder, true, true>(lds, g, S, E, wid); }
    static constexpr int L_PLAN = LDS_CTL_OFF + 4096, MAXTILE = NSLOT / 256;
    __device__ __forceinline__ void moe_tables(const P& p) {
        const unsigned t = tid_(); volatile LAS int* ps = (volatile LAS int*)(lds + L_PLAN); volatile LAS int* te = ps + 64; volatile LAS int* tb = te + MAXTILE; volatile LAS int* tmp = tb + MAXTILE;
        static_assert((64 + 2 * MAXTILE + 32) * 4 <= 4096, "plan tables");
        if (t < NE) tmp[t] = ((cursor_(p)[t * 32] + 255) >> 8) << 8;
        __syncthreads();
        if (t == 0) { int tot = 0; for (int e = 0; e < NE; ++e) { ps[e] = tot; tot += tmp[e]; } ps[NE] = tot; }
        __syncthreads();
        const int ntile = ps[NE] >> 8;
        for (int pm = t; pm < ntile; pm += NTHR) { int e = 0;
            for (int k = 1; k < NE; ++k) e += (ps[k] <= pm * 256) ? 1 : 0;
            te[pm] = e; tb[pm] = e * TT + pm * 256 - ps[e]; }
        if (blockIdx.x == 0 && t <= NE) pstart_(p)[t] = ps[t];
        __syncthreads();
    }
    template <bool GATHER, int SCW, int SCX, class Epi> __device__ __forceinline__ void gt(const void* A, const void* Bt, int K, int sh, const int* rowmap, bool sparse, const Epi& E) {
        const LAS int* ps = (const LAS int*)(lds + L_PLAN);
        pg8::Gemm g{(const bf16*)A, (const bf16*)Bt, 0, 0, K, 0}; pg8::TableOrder S; S.te = ps + 64; S.tb = sparse ? ps + 64 + MAXTILE : nullptr; S.rowmap = rowmap; S.sh = sh; S.n = (ps[NE] >> 8) << sh; S.bind((int)gridDim.x, (int)blockIdx.x, 1 << sh);
        pg8::gemm_phase<Epi, pg8::TableOrder, true, true, GATHER, true, SCW, SCX>(lds, g, S, E, wid); }
    static constexpr int TI_NONMOE = TI_WIN + TI_SQ + 2 * TI_HALF + TI_SQ;
    __device__ __forceinline__ void prep_items(const P& p, long glo, long ghi, long gw, long ngw) {
        const unsigned t_ = tid_(); const int lane = t_ & 63, w = t_ >> 6; LAS unsigned short* scr = (LAS unsigned short*)(lds + w * 16384);
        for (long it = glo + gw; it < ghi; it += ngw) { const int l = (int)(it / TI_LAYER); int r = (int)(it - (long)l * TI_LAYER); TDesc t;
            if (r < TI_WIN) { const int nb = r % 128;
                if (nb >= 76 && nb < 124) t = TDesc{p.w_in + (size_t)l * D * 7968, (bf16*)(w_g8_(p) + (size_t)l * 3072 * D - (size_t)4864 * D), D, 7968, NPAD, 1, 1};
                else t = TDesc{p.w_in + (size_t)l * D * 7968, w_in_t_(p) + (size_t)l * NPAD * D, D, 7968, NPAD, 1, 0}; }
            else if ((r -= TI_WIN) < TI_SQ) t = TDesc{p.w_br_ssd + (size_t)l * 1024 * D, w_ssd_t_(p) + (size_t)l * D * 1024, 1024, D, D, 0, 0};
            else if ((r -= TI_SQ) < TI_HALF) t = TDesc{p.w_br_swa + (size_t)l * 512 * D, w_swa_t_(p) + (size_t)l * D * 512, 512, D, D, 0, 0};
            else if ((r -= TI_HALF) < TI_HALF) t = TDesc{p.w_br_na + (size_t)l * 512 * D, w_na_t_(p) + (size_t)l * D * 512, 512, D, D, 0, 0};
            else if ((r -= TI_HALF) < TI_SQ) t = TDesc{p.w_out + (size_t)l * D * D, w_out_t_(p) + (size_t)l * D * D, D, D, D, 0, 0};
            else if ((r -= TI_SQ) < NE * TI_W1) { const int e = r / TI_W1; r %= TI_W1; t = TDesc{p.moe_w1 + ((size_t)l * NE + e) * D * 2048, (bf16*)(w1_8_(p) + ((size_t)l * NE + e) * 2048 * D), D, 2048, 2048, 2, 1}; }
            else { r -= NE * TI_W1; const int e = r / TI_SQ; r %= TI_SQ; t = TDesc{p.moe_w2 + ((size_t)l * NE + e) * D * D, (bf16*)(w2_8_(p) + ((size_t)l * NE + e) * D * D), D, D, D, 0, 1}; }
            transpose_item(t, scr, r, lane);
        }
    }
    __device__ __forceinline__ void prep_weights(const P& p) {
        prep_items(p, 0, gridDim.x == 256 && NL > 1 ? SCH_P0 : TI_ALL, (long)blockIdx.x * 8 + wid, (long)gridDim.x * 8);
    }
    __device__ __forceinline__ bool split_phase(int l, int rows) const { return l + 1 < NL && rows == TT && gridDim.x == 256; }
    __device__ __forceinline__ void prep_side(const P& p, long glo, long ghi) {
        prep_items(p, glo, ghi, (long)(blockIdx.x - GEMM_WG) * 8 + wid, (long)(gridDim.x - GEMM_WG) * 8);
    }
    __device__ __forceinline__ void ph_prologue(const P& p) {
        prep_weights(p);
        items_ns(SMALL_FLOATS, FCopySmall{p});
        items_ns((long)NL * NE * D, FRouterT{p});
        { const unsigned t = tid_(); bf16* xlb = (bf16*)xl_(p);
            for (long i = (long)blockIdx.x * NTHR + t; i < (long)TT * D / 16; i += (long)gridDim.x * NTHR) { const long e = i * 16; const float* src = e < (long)TL * D ? p.x + e : p.ctx + (e - (long)TL * D);
                const float4 a = *(const float4*)src, b = *(const float4*)(src + 4), c = *(const float4*)(src + 8), d = *(const float4*)(src + 12);
                const uint2 pa = pk4(a), pb = pk4(b), pc = pk4(c), pd = pk4(d); *(uint4*)(xlb + e) = uint4{pa.x, pa.y, pb.x, pb.y}; *(uint4*)(xlb + e + 8) = uint4{pc.x, pc.y, pd.x, pd.y}; } }
        items_ns(1024, FRopeTab{p});
        { const unsigned t = tid_(); for (int i = blockIdx.x * NTHR + t; i < NSLOT; i += gridDim.x * NTHR) ident_(p)[i] = i; }
        __syncthreads();
        { const unsigned t = tid_(); LAS float* sc = (LAS float*)lds; LAS float* part = (LAS float*)(lds + 40960);
            for (int i = t; i < 9 * D; i += NTHR) { const int r = i >> 10, k = i & 1023; sc[i] = siluf_(r < NB ? p.c[r * D + k] : p.c_ctx[k]); }
            __syncthreads();
            for (int u = blockIdx.x; u < NL * 6 * D / 128; u += gridDim.x) { const int l = u / 48, col = (u % 48) * 128 + (t & 127), kq = t >> 7;
                const float* w = p.w_ada + (size_t)l * D * 6 * D + col; float acc[9];
#pragma unroll
                for (int r = 0; r < 9; ++r) acc[r] = 0.f;
#pragma unroll 16
                for (int k = kq * 256; k < kq * 256 + 256; ++k) { const float wv = w[(size_t)k * 6 * D];
#pragma unroll
                    for (int r = 0; r < 9; ++r) acc[r] += sc[r * D + k] * wv; }
#pragma unroll
                for (int r = 0; r < 9; ++r) part[(kq * 9 + r) * 128 + (t & 127)] = acc[r];
                __syncthreads();
                for (int i = t; i < 9 * 128; i += NTHR) { const int r = i >> 7, c = i & 127, cc = (u % 48) * 128 + c;
                    mod_(p)[((size_t)(l * (NB + 1) + r)) * 6 * D + cc] = ((part[(0 * 9 + r) * 128 + c] + part[(1 * 9 + r) * 128 + c]) + part[(2 * 9 + r) * 128 + c]) + part[(3 * 9 + r) * 128 + c] + p.b_ada[(size_t)l * 6 * D + cc]; }
                __syncthreads(); } }
        sync();
    }
    __device__ __forceinline__ void ph_norm1(const P& p, int l, int combine) {
        const unsigned t = tid_(); const int lane = t & 63, gw = blockIdx.x * 8 + __builtin_amdgcn_readfirstlane(t >> 6), ngw = gridDim.x * 8;
        if (blockIdx.x == 0 && t < NE) cursor_(p)[t * 32] = 0;
        { int z = 0; asm volatile("" : "+v"(z)); for (int i = blockIdx.x * NTHR + t; i < NE * TT / 4; i += gridDim.x * NTHR) ((int4*)stok2_(p))[i] = int4{z, z, z, z}; }
        if (l == 0) {
            const int gt0 = blockIdx.x * NTHR + t, gstr = gridDim.x * NTHR;
            for (int i = gt0; i < NL * 9 * 1024; i += gstr) { const int k = i & 1023, mr = (i >> 10) % 9, ll = i / (9 * 1024);
                if (mr <= NB) n2_gm_(p)[i] = norm2_g_(p)[ll * D + k] * (1.f + mod_(p)[((size_t)(ll * (NB + 1) + mr) * 6 + 4) * D + k]); }
            for (int i = gw; i < NL * 9 * 32; i += ngw) { const int e = i & 31, mr = (i >> 5) % 9, ll = i / (9 * 32);
                if (mr <= NB) { const float* sh = mod_(p) + ((size_t)(ll * (NB + 1) + mr) * 6 + 3) * D; const float* w = router_w_(p) + (size_t)ll * D * NE + e; float a = 0.f;
#pragma unroll
                    for (int k = 0; k < 16; ++k) a += sh[lane + 64 * k] * w[(size_t)(lane + 64 * k) * NE];
                    a = wave_sum(a, lane);
                    if (lane == 0) n2_c_(p)[i] = a + router_b_(p)[ll * NE + e]; } }
            for (int i = gt0; i < NL * 32 * 2 * 64 * 8; i += gstr) { const int j = i & 7, ln = (i >> 3) & 63, tl = (i >> 9) & 1, sstep = (i >> 10) & 31, ll = i >> 15;
                const float w = router_w_(p)[((size_t)ll * D + 32 * sstep + 8 * (ln >> 4) + j) * NE + 16 * tl + (ln & 15)]; const bf16 hb = f2bf(w);
                n2_wh_(p)[i] = hb; n2_wl_(p)[i] = f2bf(w - bf2f(hb)); } }
        const float* gn = norm1_g_(p) + (size_t)l * D;
        for (int r = gw; r < TT; r += 2 * ngw) { const int rr[2] = {r, r + ngw < TT ? r + ngw : r};
            float4 v[2][4];
#pragma unroll
            for (int q = 0; q < 2; ++q)
#pragma unroll
                for (int j = 0; j < 4; ++j) v[q][j] = bf4(*(const uint2*)((const bf16*)xl_(p) + (size_t)rr[q] * D + (j * 64 + lane) * 4));
            if (combine) {
#pragma unroll
                for (int q = 0; q < 2; ++q) dev_combine(p, l - 1, rr[q], lane, v[q]);
#pragma unroll
                for (int q = 0; q < 2; ++q)
#pragma unroll
                    for (int j = 0; j < 4; ++j) *(uint2*)((bf16*)xl_(p) + (size_t)rr[q] * D + (j * 64 + lane) * 4) = pk4(v[q][j]); }
            float rstd[2];
#pragma unroll
            for (int q = 0; q < 2; ++q) rstd[q] = __builtin_amdgcn_rsqf(wave_sum((f4sq(v[q][0]) + f4sq(v[q][1])) + (f4sq(v[q][2]) + f4sq(v[q][3])), lane) * (1.f / D) + NORM_EPS);
#pragma unroll
            for (int q = 0; q < 2; ++q) { const float* sh = mod_ptr(p, l, rr[q], 0); const float* sc = mod_ptr(p, l, rr[q], 1);
#pragma unroll
                for (int j = 0; j < 4; ++j) { const int idx = (j * 64 + lane) * 4; const float4 g = *(const float4*)(gn + idx), s1 = *(const float4*)(sc + idx), b = *(const float4*)(sh + idx); const float rs = rstd[q];
                    float4 o; o.x = v[q][j].x * rs * g.x * (1.f + s1.x) + b.x; o.y = v[q][j].y * rs * g.y * (1.f + s1.y) + b.y; o.z = v[q][j].z * rs * g.z * (1.f + s1.z) + b.z; o.w = v[q][j].w * rs * g.w * (1.f + s1.w) + b.w;
                    *(uint2*)(h_(p) + (size_t)rr[q] * D + idx) = pk4(o);
                    { int q8 = __builtin_amdgcn_cvt_pk_fp8_f32(o.x, o.y, 0, false); q8 = __builtin_amdgcn_cvt_pk_fp8_f32(o.z, o.w, q8, true); *(int*)(h8n_(p) + (size_t)rr[q] * D + idx) = q8; } } } }
        sync();
    }
    __device__ __forceinline__ void gemm_win(const P& p, int l) {
        { pg8::Gemm g{h_(p), w_in_t_(p) + (size_t)l * NPAD * D, TT, 20 * 256, D, 0}; pg8::WinOrder S; S.init(TT, 20 * 256, (int)gridDim.x, (int)blockIdx.x);
            pg8::gemm_phase<pg8::EpiWin, pg8::WinOrder, true, true>(lds, g, S, pg8::EpiWin{proj_(p), dt_(p), 0, 0}, wid); }
        { pg8::Gemm g{(const bf16*)h8n_(p), (const bf16*)(w_g8_(p) + (size_t)l * 3072 * D), TT, 3072, D / 2, 0}; pg8::StaticOrderG S; S.init(TT, 3072, (int)gridDim.x, (int)gridDim.x - 1 - (int)blockIdx.x); S.rowmap = ident_(p);
            pg8::gemm_phase<pg8::EpiGate, pg8::StaticOrderG, true, true, true, true, 122, 127>(lds, g, S, pg8::EpiGate{gate8_(p), b_gate_(p) + (size_t)l * 3 * D}, wid); }
        sync(); }
    __device__ __forceinline__ void ph_conv_rope(const P& p, int l) {
        items_ns((long)(TT / 8) * 192, FConvBlk{p, l, 0}); items_ns((long)TL * 10 * 2, FRope{p});
        {
            const unsigned t = tid_(); const int lane = t & 63, wv = __builtin_amdgcn_readfirstlane(t >> 6), gw = blockIdx.x * 8 + wv, ngw = gridDim.x * 8;
            LAS float* tab = (LAS float*)(lds + wv * 16384); LAS float* wtab = tab + 512;
#pragma unroll 1
            for (int tk = gw; tk < NB * 18 * 16 * 2; tk += ngw) { const int u = tk >> 1, dir = tk & 1, hh = u & 15, c = (u >> 4) % 18, b = u / (18 * 16), row0 = ssd::chunk_row(b, c);
                ssd::tab_compute<true>(p, l, row0, hh, dir, lane, tab, wtab);
                asm volatile("s_waitcnt lgkmcnt(0)" ::: "memory");
                float* go = sstab_(p) + (size_t)u * 1536;
                go[dir * 128 + lane] = tab[dir * 128 + lane]; go[dir * 128 + 64 + lane] = tab[dir * 128 + 64 + lane];
                go[256 + dir * 128 + lane] = tab[256 + dir * 128 + lane]; go[256 + dir * 128 + 64 + lane] = tab[256 + dir * 128 + 64 + lane];
#pragma unroll
                for (int j = 0; j < 2; ++j) { const pg8::f32x4 wv4 = *(const LAS pg8::f32x4*)(wtab + dir * 512 + (j * 64 + lane) * 4); *(float4*)(go + 512 + dir * 512 + (j * 64 + lane) * 4) = float4{wv4[0], wv4[1], wv4[2], wv4[3]}; }
                asm volatile("s_waitcnt lgkmcnt(0)" ::: "memory"); } }
        sync(); }
    __device__ __forceinline__ void ph_scan(const P& p, int l) {
        using namespace ssd;
        {
            const unsigned t = tid_(); const int lane = t & 63, wv = __builtin_amdgcn_readfirstlane(t >> 6), r32 = lane & 31, hi = lane >> 5;
            LAS float* tab = (LAS float*)(lds + L_TAB);
            for (int k = 0, u; (u = ssd_unit(k)) < NB * 18 * 16; ++k) { const int hh = u & 15, c = (u >> 4) % 18, b = u / (18 * 16), g = hh >> 3, row0 = chunk_row(b, c);
                if (t < 128) { const float4 tv = *(const float4*)(sstab_(p) + (size_t)u * 1536 + 4 * t); *(LAS pg8::f32x4*)(tab + 4 * t) = pg8::f32x4{tv.x, tv.y, tv.z, tv.w}; }
                { const bf16* bsrc = xa_(p) + (size_t)row0 * 1536 + 1024 + g * 128; stage_T(bsrc, 1536, lds + L_BT, t >> 4, t & 15, [](int) { return 1.f; }); }
                __syncthreads();
                { const int t2 = t & 255, dsel = t >> 8; const float cl = tab[dsel ? 128 : 127];
                    stage_T(xa_(p) + (size_t)row0 * 1536 + hh * 64, 1536, lds + (dsel ? L_XT1 : L_XT0), t2 >> 3, t2 & 7, [&](int sidx) { return __builtin_amdgcn_exp2f(cl - tab[dsel * 128 + sidx]) * tab[256 + dsel * 128 + sidx]; }); }
                __syncthreads();
                const int dir = wv >> 2, nt = wv & 3; const size_t idx = (size_t)u * 2 + dir;
                if (t == 0) { sdec_(p)[(size_t)u * 2] = __builtin_amdgcn_exp2f(tab[127]); sdec_(p)[(size_t)u * 2 + 1] = __builtin_amdgcn_exp2f(tab[128]); }
                bf16x8 bfr[8];
#pragma unroll
                for (int k = 0; k < 8; ++k) bfr[k] = *(const LAS bf16x8*)(lds + L_BT + (32 * nt + r32) * XRS + (16 * k + 8 * hi) * 2);
                const LAS unsigned char* xt = lds + (dir ? L_XT1 : L_XT0);
#pragma unroll
                for (int pt = 0; pt < 2; ++pt) { f32x16 acc;
#pragma unroll
                    for (int r = 0; r < 16; ++r) acc[r] = 0.f;
#pragma unroll
                    for (int k = 0; k < 8; ++k) { const bf16x8 a = *(const LAS bf16x8*)(xt + (32 * pt + r32) * XRS + (16 * k + 8 * hi) * 2); acc = __builtin_amdgcn_mfma_f32_32x32x16_bf16(a, bfr[k], acc, 0, 0, 0); }
                    bf16* so = sloc_(p) + idx * 8192 + 32 * nt + r32;
#pragma unroll
                    for (int r = 0; r < 16; ++r) so[(size_t)(32 * pt + crow(r, hi)) * 128] = f2bf(acc[r]); }
                __syncthreads();
            } }
    }
    __device__ __forceinline__ void scan_s23(const P& p, int l) {
        using namespace ssd;
        {
            const unsigned t = tid_();
            for (long i = (long)blockIdx.x * NTHR + t; i < (long)NB * 16 * 2 * 1024; i += (long)gridDim.x * NTHR) { const int e8 = (int)(i & 1023), dir = (int)((i >> 10) & 1), hh = (int)((i >> 11) & 15), b = (int)(i >> 15);
                float H[8];
#pragma unroll
                for (int j = 0; j < 8; ++j) H[j] = 0.f;
#pragma unroll 1
                for (int s0 = 0; s0 < 18; s0 += 6) {
                    float dc[6]; att::u32x4 sv[6]; size_t idxs[6];
#pragma unroll
                    for (int k = 0; k < 6; ++k) { const int step = s0 + k, c = dir == 0 ? step : (step < 2 ? 1 - step : 19 - step); idxs[k] = ((size_t)(b * 18 + c) * 16 + hh) * 2 + dir;
                        dc[k] = sdec_(p)[idxs[k]]; sv[k] = *(const att::u32x4*)(sloc_(p) + idxs[k] * 8192 + e8 * 8); }
#pragma unroll
                    for (int k = 0; k < 6; ++k) { st8(hin_(p) + idxs[k] * 8192 + e8 * 8, H);
#pragma unroll
                        for (int j = 0; j < 4; ++j) { H[2 * j] = dc[k] * H[2 * j] + u2f(sv[k][j] << 16); H[2 * j + 1] = dc[k] * H[2 * j + 1] + u2f(sv[k][j] & 0xffff0000u); } } } } }
        sync();
        {
            constexpr int L_BI = L_XT0 + 64 * XRS, L_CI = L_BI + 128 * XRS, L_HF = L_CI + 128 * XRS, L_HB = L_HF + 64 * XRS;
            static_assert(L_HB + 64 * XRS <= LDS_MAIN, "S3 LDS map");
            const unsigned t = tid_(); const int lane = t & 63, wv = __builtin_amdgcn_readfirstlane(t >> 6), r32 = lane & 31, hi = lane >> 5, ti = wv >> 1, pt = wv & 1;
            LAS float* tab = (LAS float*)(lds + L_TAB); LAS float* wtab = (LAS float*)(lds + 135168);
            att::u32x4 vb[4], vc[4], vh[4], vx[4]; float4 tbv = float4{0.f, 0.f, 0.f, 0.f};
#define S3_LOAD(u_) do { const int t = (int)tid_(); const int hh_ = (u_) & 15, c_ = ((u_) >> 4) % 18, b_ = (u_) / (18 * 16), g_ = hh_ >> 3, row0_ = chunk_row(b_, c_); \
                _Pragma("unroll") for (int i = 0; i < 4; ++i) { const int id = t + 512 * i, row = id >> 4, ch = id & 15; const bf16* src = xa_(p) + (size_t)(row0_ + row) * 1536 + 1024 + g_ * 128 + ch * 8; \
                    vb[i] = *(const att::u32x4*)src; vc[i] = *(const att::u32x4*)(src + 256); } \
                _Pragma("unroll") for (int i = 0; i < 4; ++i) { const int id = t + 512 * (i & 1), row = id >> 4, ch = id & 15; vh[i] = *(const att::u32x4*)(hin_(p) + ((size_t)(u_) * 2 + (i >> 1)) * 8192 + row * 128 + ch * 8); } \
                if (t < 384) tbv = *(const float4*)(sstab_(p) + (size_t)(u_) * 1536 + 4 * t); \
                if (t < 256) { _Pragma("unroll") for (int i = 0; i < 4; ++i) vx[i] = *(const att::u32x4*)(xa_(p) + (size_t)(row0_ + 4 * (t >> 3) + i) * 1536 + hh_ * 64 + 8 * (t & 7)); } \
                asm volatile("" ::: "memory"); } while (0)
            if (ssd_unit(0) < NB * 18 * 16) S3_LOAD(ssd_unit(0));
            for (int k = 0, u; (u = ssd_unit(k)) < NB * 18 * 16; ++k) { const int hh = u & 15, c = (u >> 4) % 18, b = u / (18 * 16), row0 = chunk_row(b, c);
                {
                    const int t = (int)tid_();
                    if (t < 256) stage_T_regs(vx, lds + L_XT0, t >> 3, t & 7, [](int) { return 1.f; });
                    if (t < 128) *(LAS pg8::f32x4*)(tab + 4 * t) = pg8::f32x4{tbv.x, tbv.y, tbv.z, tbv.w}; else if (t < 384) *(LAS pg8::f32x4*)(wtab + 4 * (t - 128)) = pg8::f32x4{tbv.x, tbv.y, tbv.z, tbv.w};
#pragma unroll
                    for (int i = 0; i < 4; ++i) { const int id = t + 512 * i, row = id >> 4, ch = id & 15; *(LAS att::u32x4*)(lds + L_BI + row * XRS + ch * 16) = vb[i]; *(LAS att::u32x4*)(lds + L_CI + row * XRS + ch * 16) = vc[i]; }
#pragma unroll
                    for (int i = 0; i < 4; ++i) { const int id = t + 512 * (i & 1), row = id >> 4, ch = id & 15; *(LAS att::u32x4*)(lds + ((i >> 1) ? L_HB : L_HF) + row * XRS + ch * 16) = vh[i]; }
                }
                __syncthreads();
                { const int un = ssd_unit(k + 1); if (un < NB * 18 * 16) S3_LOAD(un); }
                const int tt = 32 * ti + r32; const float csf_t = tab[tt], cbb_t = tab[128 + tt];
                uint2 xq[4], zq[4];
#pragma unroll
                for (int gq = 0; gq < 4; ++gq) { const int ch = hh * 64 + 32 * pt + 4 * hi + 8 * gq; xq[gq] = *(const uint2*)(xa_(p) + (size_t)(row0 + tt) * 1536 + ch); zq[gq] = *(const uint2*)(proj_(p) + (size_t)(row0 + tt) * NPROJ + PC_Z + ch); }
                const float ef_t = ti > 0 ? __builtin_amdgcn_exp2f(csf_t - tab[32 * ti - 1]) : 0.f, eb_t = ti < 3 ? __builtin_amdgcn_exp2f(cbb_t - tab[128 + 32 * (ti + 1)]) : 0.f;
                bf16x8 cfr[8];
#pragma unroll
                for (int k = 0; k < 8; ++k) cfr[k] = *(const LAS bf16x8*)(lds + L_CI + tt * XRS + (16 * k + 8 * hi) * 2);
                f32x16 Y;
#pragma unroll
                for (int r = 0; r < 16; ++r) Y[r] = 0.f;
                for (int si = 0; si < 4; ++si) { f32x16 gacc;
#pragma unroll
                    for (int r = 0; r < 16; ++r) gacc[r] = 0.f;
#pragma unroll
                    for (int k = 0; k < 8; ++k) { const bf16x8 a = *(const LAS bf16x8*)(lds + L_BI + (32 * si + r32) * XRS + (16 * k + 8 * hi) * 2); gacc = __builtin_amdgcn_mfma_f32_32x32x16_bf16(a, cfr[k], gacc, 0, 0, 0); }
                    if (si == ti) {
#pragma unroll
                        for (int r = 0; r < 16; ++r) { const int sidx = 32 * si + crow(r, hi);
                            const float lf = sidx <= tt ? __builtin_amdgcn_exp2f(csf_t - tab[sidx]) * tab[256 + sidx] : 0.f, lb = sidx >= tt ? __builtin_amdgcn_exp2f(cbb_t - tab[128 + sidx]) * tab[384 + sidx] : 0.f;
                            gacc[r] *= (lf + lb); }
                    } else {
                        const float et = si < ti ? ef_t : eb_t; const LAS float* wrow = wtab + (si < ti ? 0 : 512) + ti * 128 + 32 * si + 4 * hi;
#pragma unroll
                        for (int r = 0; r < 16; ++r) gacc[r] *= et * wrow[(r & 3) + 8 * (r >> 2)]; }
#pragma unroll
                    for (int s2 = 0; s2 < 2; ++s2) { u32x4 w;
                        w.x = pg8::cvt_pk_bf16(gacc[8 * s2 + 0], gacc[8 * s2 + 1]); w.y = pg8::cvt_pk_bf16(gacc[8 * s2 + 2], gacc[8 * s2 + 3]); w.z = pg8::cvt_pk_bf16(gacc[8 * s2 + 4], gacc[8 * s2 + 5]); w.w = pg8::cvt_pk_bf16(gacc[8 * s2 + 6], gacc[8 * s2 + 7]);
                        const LAS unsigned char* a0 = lds + L_XT0 + (32 * pt + r32) * XRS + (32 * si + 16 * s2 + 4 * hi) * 2;
                        const u32x2 x0 = *(const LAS u32x2*)a0, x1 = *(const LAS u32x2*)(a0 + 16);
                        Y = __builtin_amdgcn_mfma_f32_32x32x16_bf16(__builtin_bit_cast(bf16x8, u32x4{x0.x, x0.y, x1.x, x1.y}), __builtin_bit_cast(bf16x8, w), Y, 0, 0, 0); } }
#pragma unroll
                for (int dir = 0; dir < 2; ++dir) { f32x16 z;
#pragma unroll
                    for (int r = 0; r < 16; ++r) z[r] = 0.f;
#pragma unroll
                    for (int k = 0; k < 8; ++k) { const bf16x8 a = *(const LAS bf16x8*)(lds + (dir ? L_HB : L_HF) + (32 * pt + r32) * XRS + (16 * k + 8 * hi) * 2); z = __builtin_amdgcn_mfma_f32_32x32x16_bf16(a, cfr[k], z, 0, 0, 0); }
                    const float e = __builtin_amdgcn_exp2f(dir ? cbb_t : csf_t);
#pragma unroll
                    for (int r = 0; r < 16; ++r) Y[r] += e * z[r]; }
                { const float dh = ssd_d_(p)[l * 16 + hh]; float sq = 0.f; bf16* uo = ossd_(p) + (size_t)(row0 + tt) * 1024 + hh * 64 + 32 * pt + 4 * hi; const float* gp = ssd_norm_g_(p) + (size_t)l * 1024 + hh * 64 + 32 * pt + 4 * hi;
#pragma unroll
                    for (int gq = 0; gq < 4; ++gq) { const float4 xv = bf4(xq[gq]), zv = bf4(zq[gq]), gv = *(const float4*)(gp + 8 * gq); float4 v;
                        v.x = (Y[4 * gq] + dh * xv.x) * siluf_(zv.x); v.y = (Y[4 * gq + 1] + dh * xv.y) * siluf_(zv.y); v.z = (Y[4 * gq + 2] + dh * xv.z) * siluf_(zv.z); v.w = (Y[4 * gq + 3] + dh * xv.w) * siluf_(zv.w);
                        sq += f4sq(v); *(uint2*)(uo + 8 * gq) = pk4(float4{v.x * gv.x, v.y * gv.y, v.z * gv.z, v.w * gv.w}); }
                    sq += xshf(sq, 32, lane);
                    if (hi == 0) ssq_(p)[(size_t)(row0 + tt) * 32 + hh * 2 + pt] = sq; }
                __syncthreads();
            } }
        sync();
    }
    __device__ __forceinline__ void ph_mixers(const P& p, int l, int rows) {
        { const int wv = wid; const LAS float* rpbl = (const LAS float*)(lds + att::LB_RPB);
            const int n_na = NB * 8 * 8, n_swa = NB * 2 * 32, n_ctx = rows > TL ? NB * 16 : 0;
#pragma unroll 1
            for (int u = blockIdx.x; u < n_na + n_swa + n_ctx; u += gridDim.x) {
                const unsigned t = tid_(); const int lane = t & 63, hi = lane >> 5, qi = lane & 31;
                att::State st; att::bf16x8 qf[4];
                int type, b, nbatch, qcol, kcol, vcol, hh, gr = 0, qc = 0, c0 = 0, r0 = 0, rlo = 0, rhi = 0, rwlo = 0, rwhi = 0, ws = 0, qp = 0, qhalf = wv & 1; size_t qrow; const bf16* qbase; int qstride; bf16* obase; float m0, l0;
                if (u < n_na) { type = 0; const int rg = u & 7; hh = (u >> 3) & 7; b = u >> 6; nbatch = 3;
                    const int gr0 = 4 * rg + 2 * (wv >> 2), cg = wv & 3; gr = gr0 + (qi >> 4); qc = 16 * cg + (qi & 15); ws = cg == 0 ? 0 : (cg == 1 ? 8 : (cg == 2 ? 24 : 32));
                    qrow = (size_t)b * S + gr * GW + qc - qi;
                    qcol = PC_QN + hh * 64; kcol = PC_KN + hh * 64; vcol = PC_VN + hh * 64; qbase = proj_(p) + qcol; qstride = NPROJ; obase = ona_(p); m0 = -1e30f; l0 = 0.f;
                    r0 = gr - 4 < 0 ? 0 : (gr - 4 > 24 ? 24 : gr - 4); c0 = qc - 8 < 0 ? 0 : (qc - 8 > 48 ? 48 : qc - 8);
                    rwlo = gr0 - 4 < 0 ? 0 : (gr0 - 4 > 24 ? 24 : gr0 - 4); rwhi = (gr0 - 3 < 0 ? 0 : (gr0 - 3 > 24 ? 24 : gr0 - 3)) + 7;
                    rlo = 4 * rg - 4 < 0 ? 0 : (4 * rg - 4 > 24 ? 24 : 4 * rg - 4); rhi = (4 * rg - 1 < 0 ? 0 : (4 * rg - 1 > 24 ? 24 : 4 * rg - 1)) + 7; }
                else if (u < n_na + n_swa) { type = 1; const int v = u - n_na; qp = v & 31; const int kvh = (v >> 5) & 1; b = v >> 6; hh = kvh * 4 + (wv >> 1); qrow = (size_t)b * S + 64 * qp + 32 * qhalf; nbatch = 2;
                    kcol = PC_KS + kvh * 64; vcol = PC_VS + kvh * 64; qcol = hh * 64; qbase = qsr_(p) + qcol; qstride = 512; obase = oswa_(p); m0 = swa_sink_(p)[l * 8 + hh] * att::LOG2E; l0 = lane < 32 ? 1.f : 0.f; }
                else { const int v = u - n_na - n_swa; nbatch = 1; int qt;
                    if (v < NB * 8) { type = 2; const int kvh = (v >> 2) & 1; b = v >> 3; hh = kvh * 4 + (wv >> 1); qt = 2 * (v & 3) + qhalf; qcol = PC_QS + hh * 64; kcol = PC_KS + kvh * 64; vcol = PC_VS + kvh * 64; obase = oswa_(p); m0 = swa_sink_(p)[l * 8 + hh] * att::LOG2E; l0 = lane < 32 ? 1.f : 0.f; }
                    else { type = 3; const int w2 = v - NB * 8; hh = w2 & 7; b = w2 >> 3; qt = wv; qcol = PC_QN + hh * 64; kcol = PC_KN + hh * 64; vcol = PC_VN + hh * 64; obase = ona_(p); m0 = -1e30f; l0 = 0.f; }
                    qrow = (size_t)TL + b * LC + 32 * qt; qbase = proj_(p) + qcol; qstride = NPROJ; }
                att::load_q_at(qf, qbase + (qrow + qi) * qstride, lane); att::init(st, m0, l0);
#pragma unroll 1
                for (int bt = 0; bt < nbatch; ++bt) {
                    const bool is_ctx = bt == nbatch - 1;
                    int nt, rbase, seq_lo; const bf16* kbase; int kstride;
                    if (is_ctx) { nt = 8; rbase = TL + b * LC; seq_lo = rbase; kbase = proj_(p) + kcol; kstride = NPROJ; }
                    else if (type == 0) { const int kr0 = bt == 0 ? rlo : rlo + 6, kr1 = bt == 0 ? (rlo + 5 < rhi ? rlo + 5 : rhi) : rhi; nt = 2 * (kr1 - kr0 + 1); rbase = b * S + kr0 * GW; seq_lo = b * S; kbase = proj_(p) + kcol; kstride = NPROJ; }
                    else { nt = 10; rbase = b * S + 64 * qp - 128; seq_lo = b * S; kbase = ksr_(p) + (kcol - PC_KS); kstride = 128; }
                    const bf16* vbase = proj_(p) + vcol; const int seq_hi = is_ctx ? seq_lo + LC : seq_lo + S;
                    __syncthreads();
                    if (type == 0 && bt == 0) { const float* rpb = na_rpb_(p) + (size_t)(l * 8 + hh) * 15 * 31; if (t < 15 * 31) ((LAS float*)rpbl)[t] = rpb[t] * 8.f; }
                    att::stage_batch(lds, nt, [&](int tl, const bf16*& kp, int& ks, const bf16*& vp, int& vs) { int row = rbase + 32 * tl; row = (row < seq_lo || row >= seq_hi) ? seq_lo : row;
                        kp = kbase + (size_t)row * kstride; ks = kstride; vp = vbase + (size_t)row * NPROJ; vs = NPROJ; }, t);
                    __syncthreads();
                    const bool na_loc = type == 0 && !is_ctx; const int tstep = na_loc ? 2 : 1;
#pragma unroll 1
                    for (int tl = 0; tl < nt; tl += tstep) { int mode = 0, d0 = 0, koff = tl * 32; bool rowok = true; const LAS float* brow2 = rpbl;
                        if (!is_ctx) {
                            if (type == 0) { const int kr = (rbase - b * S) / GW + (tl >> 1); if (kr < rwlo || kr > rwhi) continue; mode = 3; koff += ws; rowok = kr >= r0 && kr < r0 + 8;
                                d0 = ws + 4 * hi - c0; brow2 = rpbl + (kr - gr + 7) * 31 + 15 - qc + ws + 4 * hi; }
                            else { const int row = rbase + 32 * tl, rel = tl - qhalf; if (rel < 0 || rel > 8 || row < seq_lo || row >= seq_hi) continue; mode = rel == 0 ? 1 : (rel == 8 ? 2 : 0); } }
                        if (mode == 3) { float bv[16];
#pragma unroll
                            for (int r = 0; r < 16; ++r) bv[r] = brow2[(r & 3) + 8 * (r >> 2)];
                            att::compute_lds(st, qf, lds, koff, lane, [&](int r, float sv) { return (rowok && (unsigned)(d0 + (r & 3) + 8 * (r >> 2)) < 16u) ? sv + bv[r] : -INFINITY; }); }
                        else if (mode == 1) att::compute_lds(st, qf, lds, koff, lane, [&](int r, float sv) { return (r & 3) + 8 * (r >> 2) + 4 * hi >= qi ? sv : -INFINITY; });
                        else if (mode == 2) att::compute_lds(st, qf, lds, koff, lane, [&](int r, float sv) { return (r & 3) + 8 * (r >> 2) + 4 * hi <= qi ? sv : -INFINITY; });
                        else att::compute_lds(st, qf, lds, koff, lane, att::NoMask{}); }
                }
                att::finish_at(st, obase + (qrow + qi) * 512 + hh * 64, lane);
            }
            __syncthreads(); }
        sync();
        scan_s23(p, l);
    }
    __device__ __forceinline__ void gemm_merge(const P& p, int l, int rows) {
        const unsigned char* g = gate8_(p); const float* bg = b_gate_(p) + (size_t)l * 3 * D;
        const bool split = split_phase(l, rows); const int G = split ? GEMM_WG : 0;
        if (split && (int)blockIdx.x >= GEMM_WG) prep_side(p, sch_merge_lo(l), sch_wout_lo(l));
        gs(ossd_(p), w_ssd_t_(p) + (size_t)l * D * 1024, rows, D, 1024, pg8::EpiMerge<0>{g, bg, macc_(p), m_(p), ssq_(p)}, G);
        gs(oswa_(p), w_swa_t_(p) + (size_t)l * D * 512, rows, D, 512, pg8::EpiMerge<1>{g + 1024, bg + 1024, macc_(p), m_(p), nullptr}, G);
        gs(ona_(p), w_na_t_(p) + (size_t)l * D * 512, rows, D, 512, pg8::EpiMerge<2>{g + 2048, bg + 2048, macc_(p), m_(p), nullptr}, G);
        sync(); }
    __device__ __forceinline__ void gemm_wout(const P& p, int l, int rows, float scale = 1.f) {
        const bool split = split_phase(l, rows);
        if (split && (int)blockIdx.x >= GEMM_WG && scale != 0.f) prep_side(p, sch_wout_lo(l), sch_wout_hi(l));
        gs(m_(p), w_out_t_(p) + (size_t)l * D * D, rows, D, D, pg8::EpiWout{xl_(p), mod_(p) + (size_t)l * (NB + 1) * 6 * D, scale, 0}, split ? GEMM_WG : 0); sync(); }
    __device__ __forceinline__ void ph_norm2(const P& p, int l, int rows, int count = 1) {
        const unsigned t = tid_(); const int lane = t & 63, r = lane & 15, q = lane >> 4, wv = __builtin_amdgcn_readfirstlane(t >> 6), ntile = rows / 16, G = (int)gridDim.x;
        volatile LAS int* hist = (volatile LAS int*)(lds + LDS_CTL_OFF + 256); volatile LAS int* lbase = (volatile LAS int*)(lds + LDS_CTL_OFF + 384);
        const att::bf16x8* whf = (const att::bf16x8*)(n2_wh_(p) + (size_t)l * 32 * 2 * 64 * 8); const att::bf16x8* wlf = (const att::bf16x8*)(n2_wl_(p) + (size_t)l * 32 * 2 * 64 * 8);
#pragma unroll 1
        for (int tb0 = 0; tb0 < ntile; tb0 += 8 * G) {
            const int tile = tb0 + wv * G + (int)blockIdx.x; const bool act = tile < ntile; const int row = tile * 16 + r, mr = act ? mod_row(tile * 16) : 0;
            if (t < NE) hist[t] = 0;
            __syncthreads();
            float rstd = 0.f; int ti[4] = {0, 0, 0, 0}, rk[4] = {0, 0, 0, 0};
            const bf16* xr = (const bf16*)xl_(p) + (size_t)row * D + 8 * q; const float* gm = n2_gm_(p) + (size_t)(l * 9 + mr) * 1024 + 8 * q;
            if (act) {
            pg8::f32x4 acc0 = {0.f, 0.f, 0.f, 0.f}, acc1 = {0.f, 0.f, 0.f, 0.f}; float ssq = 0.f;
#pragma unroll 2
            for (int s2 = 0; s2 < 32; ++s2) { const uint4 xw = *(const uint4*)(xr + 32 * s2); const float4 xa = bf4(uint2{xw.x, xw.y}), xb = bf4(uint2{xw.z, xw.w}), ga = *(const float4*)(gm + 32 * s2), gb = *(const float4*)(gm + 32 * s2 + 4);
                const att::bf16x8 wh0 = whf[(s2 * 2 + 0) * 64 + lane], wh1 = whf[(s2 * 2 + 1) * 64 + lane], wl0 = wlf[(s2 * 2 + 0) * 64 + lane], wl1 = wlf[(s2 * 2 + 1) * 64 + lane];
                ssq += f4sq(xa) + f4sq(xb);
                const float u[8] = {xa.x * ga.x, xa.y * ga.y, xa.z * ga.z, xa.w * ga.w, xb.x * gb.x, xb.y * gb.y, xb.z * gb.z, xb.w * gb.w};
                att::u32x4 uh, ul;
#pragma unroll
                for (int j = 0; j < 4; ++j) { const unsigned hp = pg8::cvt_pk_bf16(u[2 * j], u[2 * j + 1]); uh[j] = hp; ul[j] = pg8::cvt_pk_bf16(u[2 * j] - u2f(hp << 16), u[2 * j + 1] - u2f(hp & 0xffff0000u)); }
                const att::bf16x8 uhf = __builtin_bit_cast(att::bf16x8, uh), ulf = __builtin_bit_cast(att::bf16x8, ul);
                acc0 = __builtin_amdgcn_mfma_f32_16x16x32_bf16(wh0, uhf, acc0, 0, 0, 0); acc1 = __builtin_amdgcn_mfma_f32_16x16x32_bf16(wh1, uhf, acc1, 0, 0, 0);
                acc0 = __builtin_amdgcn_mfma_f32_16x16x32_bf16(wh0, ulf, acc0, 0, 0, 0); acc1 = __builtin_amdgcn_mfma_f32_16x16x32_bf16(wh1, ulf, acc1, 0, 0, 0);
                acc0 = __builtin_amdgcn_mfma_f32_16x16x32_bf16(wl0, uhf, acc0, 0, 0, 0); acc1 = __builtin_amdgcn_mfma_f32_16x16x32_bf16(wl1, uhf, acc1, 0, 0, 0); }
            ssq += xshf(ssq, 16, lane); ssq += xshf(ssq, 32, lane);
            rstd = __builtin_amdgcn_rsqf(ssq * (1.f / D) + NORM_EPS);
            const float* cc = n2_c_(p) + (size_t)(l * 9 + mr) * 32 + 4 * q; const float4 c0 = *(const float4*)cc, c1 = *(const float4*)(cc + 16);
            float lg[8] = {rstd * acc0[0] + c0.x, rstd * acc0[1] + c0.y, rstd * acc0[2] + c0.z, rstd * acc0[3] + c0.w, rstd * acc1[0] + c1.x, rstd * acc1[1] + c1.y, rstd * acc1[2] + c1.z, rstd * acc1[3] + c1.w};
            float tv[4];
#pragma unroll
            for (int k = 0; k < 4; ++k) { float bv = lg[0]; int bi = 0;
#pragma unroll
                for (int i = 1; i < 8; ++i) { const bool g2 = lg[i] > bv; bv = g2 ? lg[i] : bv; bi = g2 ? i : bi; }
                int be = (bi < 4 ? 4 * q + bi : 16 + 4 * q + (bi - 4));
#pragma unroll
                for (int o = 16; o < 64; o <<= 1) { const float ov = xshf(bv, o, lane); const int oe = xshi(be, o, lane); const bool tk = ov > bv || (ov == bv && oe < be); bv = tk ? ov : bv; be = tk ? oe : be; }
                tv[k] = bv; ti[k] = be;
#pragma unroll
                for (int i = 0; i < 8; ++i) { const int ei = (i < 4 ? 4 * q + i : 16 + 4 * q + (i - 4)); lg[i] = ei == be ? -3e38f : lg[i]; } }
            if (q == 0) { const float e1 = fexp_(tv[1] - tv[0]), e2 = fexp_(tv[2] - tv[0]), e3 = fexp_(tv[3] - tv[0]), inv = 1.f / (1.f + e1 + e2 + e3);
                *(float4*)(topw_(p) + row * 4) = float4{inv, e1 * inv, e2 * inv, e3 * inv};
                if (count) {
#pragma unroll
                    for (int k = 0; k < 4; ++k) rk[k] = __hip_atomic_fetch_add((LAS int*)&hist[ti[k]], 1, __ATOMIC_RELAXED, __HIP_MEMORY_SCOPE_WORKGROUP); } }
            }
            __syncthreads();
            int gbase = 0; if (t < NE && count) { const int c = hist[t]; gbase = c ? atomicAdd(cursor_(p) + t * 32, c) : 0; }
            if (act) {
            const float* sh = mod_ptr(p, l, row, 3) + 8 * q; unsigned char* ho = h8_(p) + (size_t)row * D + 8 * q;
#pragma unroll 4
            for (int s2 = 0; s2 < 32; ++s2) { const uint4 xw = *(const uint4*)(xr + 32 * s2); const float4 xa = bf4(uint2{xw.x, xw.y}), xb = bf4(uint2{xw.z, xw.w}), ga = *(const float4*)(gm + 32 * s2), gb = *(const float4*)(gm + 32 * s2 + 4), sa = *(const float4*)(sh + 32 * s2), sb = *(const float4*)(sh + 32 * s2 + 4);
                int lo = __builtin_amdgcn_cvt_pk_fp8_f32(xa.x * rstd * ga.x + sa.x, xa.y * rstd * ga.y + sa.y, 0, false); lo = __builtin_amdgcn_cvt_pk_fp8_f32(xa.z * rstd * ga.z + sa.z, xa.w * rstd * ga.w + sa.w, lo, true);
                int hi2 = __builtin_amdgcn_cvt_pk_fp8_f32(xb.x * rstd * gb.x + sb.x, xb.y * rstd * gb.y + sb.y, 0, false); hi2 = __builtin_amdgcn_cvt_pk_fp8_f32(xb.z * rstd * gb.z + sb.z, xb.w * rstd * gb.w + sb.w, hi2, true);
                *(uint2*)(ho + 32 * s2) = uint2{(unsigned)lo, (unsigned)hi2}; } }
            if (t < NE) lbase[t] = gbase;
            __syncthreads();
            if (act && q == 0 && count) { int so[4];
#pragma unroll
                for (int k = 0; k < 4; ++k) { const int rank = lbase[ti[k]] + rk[k]; stok2_(p)[ti[k] * TT + rank] = row; so[k] = (ti[k] << 20) | rank; }
                *(int4*)(slot_of_(p) + row * 4) = int4{so[0], so[1], so[2], so[3]}; }
        }
        sync();
    }
    __device__ __forceinline__ void ph_moe_plan(const P&, int, int) {}
    __device__ __forceinline__ void gemm_moe1(const P& p, int l) { moe_tables(p); gt<true, 122, 127>(h8_(p), w1_8_(p) + (size_t)l * NE * 2048 * D, D / 2, 3, stok2_(p), true, pg8::EpiMoe1F8{act8_(p), moe_b1_(p) + (size_t)l * NE * 2048}); sync(); }
    __device__ __forceinline__ void gemm_moe2(const P& p, int l) { gt<true, 122, 125>(act8_(p), w2_8_(p) + (size_t)l * NE * D * D, D / 2, 2, ident_(p), false, pg8::EpiMoe2{ys_(p), moe_b2_(p) + (size_t)l * NE * D}); sync(); }
    __device__ __forceinline__ void ph_final(const P& p) {
        const unsigned t = tid_(); const int lane = t & 63, gw = blockIdx.x * 8 + __builtin_amdgcn_readfirstlane(t >> 6), ngw = gridDim.x * 8;
        for (int r = gw; r < TL; r += 2 * ngw) { const int rr[2] = {r, r + ngw < TL ? r + ngw : r};
            float4 v[2][4];
#pragma unroll
            for (int q = 0; q < 2; ++q)
#pragma unroll
                for (int j = 0; j < 4; ++j) v[q][j] = bf4(*(const uint2*)((const bf16*)xl_(p) + (size_t)rr[q] * D + (j * 64 + lane) * 4));
#pragma unroll
            for (int q = 0; q < 2; ++q) dev_combine(p, NL - 1, rr[q], lane, v[q]);
#pragma unroll
            for (int q = 0; q < 2; ++q) { const float rstd = __builtin_amdgcn_rsqf(wave_sum((f4sq(v[q][0]) + f4sq(v[q][1])) + (f4sq(v[q][2]) + f4sq(v[q][3])), lane) * (1.f / D) + NORM_EPS);
#pragma unroll
                for (int j = 0; j < 4; ++j) { const int idx = (j * 64 + lane) * 4; const float4 g = *(const float4*)(final_g_(p) + idx);
                    *(float4*)(p.out + (size_t)rr[q] * D + idx) = float4{v[q][j].x * rstd * g.x, v[q][j].y * rstd * g.y, v[q][j].z * rstd * g.z, v[q][j].w * rstd * g.w}; } } }
    }
};

__global__ void __launch_bounds__(NTHR, 2) mega_fwd(P p) {
    extern __shared__ __attribute__((aligned(16))) unsigned char lds_raw[];
    LAS unsigned char* lds = (LAS unsigned char*)lds_raw;
    volatile LAS unsigned* ctlw = (volatile LAS unsigned*)(lds + LDS_CTL_OFF);
    if (threadIdx.x < 64) ctlw[threadIdx.x] = 0u;
    __syncthreads();
    MegaEx ex{lds, xcd_barrier_post(ctl_(p) + 4096, ctlw + 8), __builtin_amdgcn_readfirstlane((int)(threadIdx.x >> 6))};
    forward(ex, p);
}

extern "C" void kernel_launch(void* const* d_in, const int* in_sizes, int n_in, void* d_out, int out_size, void* d_ws, size_t ws_size, hipStream_t stream) {
    static int grid = 0;
    P p{}; bind_inputs(p, d_in, d_out, d_ws);
    const size_t need = WS_TOTAL;
    if (grid == 0) {
        if (n_in != 29 || need > ws_size) { fprintf(stderr, "kernel_launch: need %zu bytes of workspace, have %zu (n_in %d)\n", need, ws_size, n_in); grid = -1; return; }
        int dev = 0, cus = 0, per_cu = 0;
        if (hipGetDevice(&dev) != hipSuccess || hipDeviceGetAttribute(&cus, hipDeviceAttributeMultiprocessorCount, dev) != hipSuccess) { grid = -1; return; }
        if (hipFuncSetAttribute((const void*)mega_fwd, hipFuncAttributeMaxDynamicSharedMemorySize, LDS_BYTES) != hipSuccess) { fprintf(stderr, "kernel_launch: hipFuncSetAttribute failed\n"); grid = -1; return; }
        if (hipOccupancyMaxActiveBlocksPerMultiprocessor(&per_cu, (const void*)mega_fwd, NTHR, LDS_BYTES) != hipSuccess || per_cu < 1) { fprintf(stderr, "kernel_launch: occupancy query says %d blocks per CU\n", per_cu); (void)hipGetLastError(); grid = -1; return; }
        grid = cus;
    }
    if (grid < 0) return;
    (void)hipMemsetAsync(ctl_(p), 0, 1 << 20, stream);
    hipLaunchKernelGGL(mega_fwd, dim3(grid), dim3(NTHR), LDS_BYTES, stream, p);
}
#endif
```

```cpp
#ifndef HOST_EMU
#include <hip/hip_runtime.h>
#include <cstdio>
#include <cstdint>
#define HD __host__ __device__ __forceinline__
#else
#include <cstdio>
#include <cstdint>
#include <cstring>
#include <cmath>
#include <cstdlib>
#define HD inline
struct uint4 { unsigned x, y, z, w; };
struct float4 { float x, y, z, w; };
#endif

typedef unsigned short bf16;

#ifndef NB_
#define NB_ 8
#define NL_ 4
#endif
constexpr int NB = NB_, NL = NL_;
constexpr int S = 2048, LC = 256, D = 1024, GW = 64;
constexpr int NPROJ = 7936, NPAD = 8192;
constexpr int PC_Z = 0, PC_XBC = 1024, PC_QS = 2560, PC_KS = 3072, PC_VS = 3200, PC_QN = 3328, PC_KN = 3840, PC_VN = 4352, PC_G = 4864;
constexpr int NE = 32, TOPK = 4;
constexpr float NORM_EPS = 1e-6f;
constexpr int TL = NB * S, TC = NB * LC, TT = TL + TC, NSLOT = TT * 4 + NE * 256;

struct P {
    const float *x, *c, *ctx, *c_ctx, *w_ada, *b_ada, *w_in, *w_br_ssd, *w_br_swa, *w_br_na, *w_out, *moe_w1, *moe_w2;
    const float* small_in[16];
    float* out; char* ws;
};
#define WS_LIST(X) \
    X(ctl, unsigned, (size_t)1 << 20) \
    X(xl, float, (size_t)TT * D * 4) X(mod, float, (size_t)NL * (NB + 1) * 6 * D * 4) X(dt, float, (size_t)TT * 32 * 4) \
    X(yf, float, (size_t)TT * 1024 * 4) X(yb, float, (size_t)TT * 1024 * 4) X(macc, float, (size_t)TT * D * 4) X(topw, float, (size_t)TT * 4 * 4) \
    X(h, bf16, (size_t)TT * D * 2) X(proj, bf16, (size_t)TT * NPROJ * 2) X(xa, bf16, (size_t)TT * 1536 * 2) X(qsr, bf16, (size_t)TL * 512 * 2) X(ksr, bf16, (size_t)TL * 128 * 2) \
    X(ossd, bf16, (size_t)TT * 1024 * 2) X(oswa, bf16, (size_t)TT * 512 * 2) X(ona, bf16, (size_t)TT * 512 * 2) X(m, bf16, (size_t)TT * D * 2) \
    X(xs, bf16, (size_t)NSLOT * D * 2) X(act, bf16, (size_t)NSLOT * D * 2) X(ys, bf16, (size_t)NSLOT * D * 2) \
    X(topi, int, (size_t)TT * 4 * 4) X(slot_of, int, (size_t)TT * 4 * 4) X(cnt, int, 4096) X(cursor, int, 4096) X(pstart, int, 4096) X(nunits, int, 4096) \
    X(slot_tok, int, (size_t)NSLOT * 4) X(stok2, int, (size_t)NE * TT * 4) X(units1, int, (size_t)(NSLOT / 256) * 8 * 4) X(units2, int, (size_t)(NSLOT / 256) * 4 * 4) \
    X(w_in_t, bf16, (size_t)NL * NPAD * D * 2) X(w_ssd_t, bf16, (size_t)NL * D * 1024 * 2) X(w_swa_t, bf16, (size_t)NL * D * 512 * 2) X(w_na_t, bf16, (size_t)NL * D * 512 * 2) \
    X(h8n, unsigned char, (size_t)TT * 1024) X(gate8, unsigned char, (size_t)TT * 3072) X(w_g8, unsigned char, (size_t)NL * 3072 * 1024) X(h8, unsigned char, (size_t)TT * 1024) X(act8, unsigned char, (size_t)NSLOT * 1024) X(w1_8, unsigned char, (size_t)NL * NE * 2048 * 1024) X(w2_8, unsigned char, (size_t)NL * NE * 1024 * 1024) X(ident, int, (size_t)NSLOT * 4) X(n2_gm, float, (size_t)NL * 9 * 1024 * 4) X(n2_c, float, (size_t)NL * 9 * 32 * 4) X(n2_wh, bf16, (size_t)NL * 32 * 2 * 64 * 8 * 2) X(n2_wl, bf16, (size_t)NL * 32 * 2 * 64 * 8 * 2) X(sstab, float, (size_t)NB * 18 * 16 * 1536 * 4) X(ssq, float, (size_t)TT * 32 * 4) X(rstd, float, (size_t)TT * 4) X(router_wT, float, (size_t)NL * NE * D * 4) X(rope_tab, float, 64 * 16 * 2 * 4) X(sloc, bf16, (size_t)NB * 18 * 16 * 2 * 8192 * 2) X(sdec, float, (size_t)NB * 18 * 16 * 2 * 4) X(hin, bf16, (size_t)NB * 18 * 16 * 2 * 8192 * 2) X(w_out_t, bf16, (size_t)NL * D * D * 2) X(w1_t, bf16, (size_t)NL * NE * 2048 * D * 2) X(w2_t, bf16, (size_t)NL * NE * D * D * 2) \
    SMALL_LIST(X)
#define SMALL_LIST(X) \
    X(norm1_g, float, (size_t)NL * D * 4) X(norm2_g, float, (size_t)NL * D * 4) X(b_gate, float, (size_t)NL * 3 * D * 4) X(conv_w, float, (size_t)NL * 5 * 1536 * 4) X(conv_b, float, (size_t)NL * 1536 * 4) \
    X(a_log, float, (size_t)NL * 32 * 4) X(dt_bias, float, (size_t)NL * 32 * 4) X(ssd_d, float, (size_t)NL * 16 * 4) X(ssd_norm_g, float, (size_t)NL * 1024 * 4) X(swa_sink, float, (size_t)NL * 8 * 4) \
    X(na_rpb, float, (size_t)NL * 8 * 15 * 31 * 4) X(router_w, float, (size_t)NL * D * NE * 4) X(router_b, float, (size_t)NL * NE * 4) X(moe_b1, float, (size_t)NL * NE * 2048 * 4) X(moe_b2, float, (size_t)NL * NE * D * 4) X(final_g, float, (size_t)D * 4)
constexpr int SMALL_IDX[16] = {4, 5, 9, 10, 11, 12, 13, 14, 15, 16, 17, 22, 23, 25, 27, 28};
#define X(name, T, bytes) WS_##name,
enum { WS_LIST(X) WS_COUNT };
#undef X
#define X(name, T, bytes) (bytes),
constexpr size_t WS_SIZES[WS_COUNT] = { WS_LIST(X) };
#undef X
constexpr size_t ws_off(int i) { size_t o = 0; for (int k = 0; k < i; ++k) o += (WS_SIZES[k] + 4095) & ~(size_t)4095; return o; }
constexpr size_t WS_TOTAL = ws_off(WS_COUNT);
#define X(name, T, bytes) HD T* name##_(const P& p) { constexpr size_t o = ws_off(WS_##name); return (T*)(p.ws + o); }
WS_LIST(X)
#undef X
constexpr int WS_SMALL0 = WS_norm1_g;
static void bind_inputs(P& p, void* const* d_in, void* d_out, void* ws) {
    const int big[13] = {0, 1, 2, 3, 6, 7, 8, 18, 19, 20, 21, 24, 26}; const float** f = (const float**)&p.x;
    for (int i = 0; i < 13; ++i) f[i] = (const float*)d_in[big[i]];
    for (int i = 0; i < 16; ++i) p.small_in[i] = (const float*)d_in[SMALL_IDX[i]];
    p.out = (float*)d_out; p.ws = (char*)ws;
}

HD unsigned f2u(float f) { unsigned u; __builtin_memcpy(&u, &f, 4); return u; }
HD float u2f(unsigned u) { float f; __builtin_memcpy(&f, &u, 4); return f; }
HD bf16 f2bf(float f) { unsigned u = f2u(f); return (bf16)((u + 0x7fffu + ((u >> 16) & 1u)) >> 16); }
HD float bf2f(bf16 b) { return u2f(((unsigned)b) << 16); }
HD unsigned pk2(float lo, float hi) { return (unsigned)f2bf(lo) | ((unsigned)f2bf(hi) << 16); }
#if defined(__HIP_DEVICE_COMPILE__)
HD float fexp_(float x) { return __builtin_amdgcn_exp2f(x * 1.4426950408889634f); }
HD float sigmoidf_(float x) { return __builtin_amdgcn_rcpf(1.f + fexp_(-x)); }
HD float siluf_(float x) { return x * __builtin_amdgcn_rcpf(1.f + fexp_(-x)); }
HD float softplusf_(float x) { return x > 20.f ? x : __builtin_amdgcn_logf(1.f + fexp_(x)) * 0.6931471805599453f; }
#else
HD float fexp_(float x) { return expf(x); }
HD float sigmoidf_(float x) { return 1.f / (1.f + expf(-x)); }
HD float siluf_(float x) { return x / (1.f + expf(-x)); }
HD float softplusf_(float x) { return x > 20.f ? x : log1pf(expf(x)); }
#endif
HD void ld8(const bf16* p, float* o) {
    const uint4 v = *(const uint4*)p;
    o[0] = u2f(v.x << 16); o[1] = u2f(v.x & 0xffff0000u); o[2] = u2f(v.y << 16); o[3] = u2f(v.y & 0xffff0000u);
    o[4] = u2f(v.z << 16); o[5] = u2f(v.z & 0xffff0000u); o[6] = u2f(v.w << 16); o[7] = u2f(v.w & 0xffff0000u);
}
HD void st8(bf16* p, const float* v) { uint4 o; o.x = pk2(v[0], v[1]); o.y = pk2(v[2], v[3]); o.z = pk2(v[4], v[5]); o.w = pk2(v[6], v[7]); *(uint4*)p = o; }
HD int mod_row(int r) { return r < TL ? r / S : NB; }
HD const float* mod_ptr(const P& p, int l, int r, int chunk) { return mod_(p) + ((size_t)(l * (NB + 1) + mod_row(r)) * 6 + chunk) * D; }
HD int win_src(int n) { return n < 2560 ? n : n < 7936 ? n + 32 : n < 7968 ? n - 7936 + 2560 : -1; }
HD int w1_src(int n) { const int j = n >> 8, i = n & 255; return i < 128 ? 128 * j + i : 1024 + 128 * j + (i - 128); }
#ifdef HOST_EMU
static inline int atomic_add_i(int* p, int v) { return __atomic_fetch_add(p, v, __ATOMIC_RELAXED); }
#else
__device__ __forceinline__ int atomic_add_i(int* p, int v) { return atomicAdd(p, v); }
#endif

struct FInit { P p; HD void operator()(long i) const {
    const long e = i * 16; const float* src = e < (long)TL * D ? p.x + e : p.ctx + (e - (long)TL * D); const float4 a = *(const float4*)src, b = *(const float4*)(src + 4), c = *(const float4*)(src + 8), d = *(const float4*)(src + 12);
    float* dst = xl_(p) + e; *(float4*)dst = a; *(float4*)(dst + 4) = b; *(float4*)(dst + 8) = c; *(float4*)(dst + 12) = d; } };

struct FCopySmall { P p; HD void operator()(long i) const {
    long o = i;
#define X(name, T, bytes) { constexpr long n_ = (long)((bytes) / 4); if (o >= 0 && o < n_) name##_(p)[o] = p.small_in[WS_##name - WS_SMALL0][o]; o -= n_; }
    SMALL_LIST(X)
#undef X
} };
#define X(name, T, bytes) + (long)((bytes) / 4)
constexpr long SMALL_FLOATS = 0 SMALL_LIST(X);
#undef X

struct FAda { P p; HD void operator()(long i) const {
    const int l = (int)(i / (6 * D)), col = (int)(i % (6 * D)); const float* w = p.w_ada + (size_t)l * D * 6 * D + col;
    float acc[9];
#pragma unroll
    for (int r = 0; r < 9; ++r) acc[r] = 0.f;
    for (int k = 0; k < D; ++k) { const float wv = w[(size_t)k * 6 * D];
#pragma unroll
        for (int r = 0; r < 9; ++r) { if (r <= NB) { const float cv = r < NB ? p.c[r * D + k] : p.c_ctx[k]; acc[r] += siluf_(cv) * wv; } } }
#pragma unroll
    for (int r = 0; r < 9; ++r) if (r <= NB) mod_(p)[((size_t)(l * (NB + 1) + r)) * 6 * D + col] = acc[r] + p.b_ada[(size_t)l * 6 * D + col]; } };

HD void moe_combine_row(const P& p, int lp, int r) {
    const float* g2 = mod_ptr(p, lp, r, 5); float* xr = xl_(p) + (size_t)r * D;
    const int s0 = slot_of_(p)[r * 4 + 0], s1 = slot_of_(p)[r * 4 + 1], s2 = slot_of_(p)[r * 4 + 2], s3 = slot_of_(p)[r * 4 + 3];
    const float w0 = topw_(p)[r * 4 + 0], w1 = topw_(p)[r * 4 + 1], w2 = topw_(p)[r * 4 + 2], w3 = topw_(p)[r * 4 + 3];
    for (int k = 0; k < D; k += 8) { float a[8], b[8], c[8], d[8];
        ld8(ys_(p) + (size_t)s0 * D + k, a); ld8(ys_(p) + (size_t)s1 * D + k, b); ld8(ys_(p) + (size_t)s2 * D + k, c); ld8(ys_(p) + (size_t)s3 * D + k, d);
        for (int j = 0; j < 8; ++j) xr[k + j] += g2[k + j] * (((w0 * a[j] + w1 * b[j]) + w2 * c[j]) + w3 * d[j]); } }

struct FNorm1 { P p; int l, combine; HD void operator()(long i) const {
    const int r = (int)i; if (r < NE) { cnt_(p)[r] = 0; cursor_(p)[r] = 0; }
    if (combine) moe_combine_row(p, l - 1, r);
    const float* xr = xl_(p) + (size_t)r * D; float ss = 0.f;
    for (int k = 0; k < D; ++k) ss += xr[k] * xr[k];
    const float rstd = 1.f / sqrtf(ss * (1.f / D) + NORM_EPS);
    const float* sh = mod_ptr(p, l, r, 0); const float* sc = mod_ptr(p, l, r, 1); const float* g = norm1_g_(p) + (size_t)l * D;
    for (int k = 0; k < D; k += 8) { float v[8];
        for (int j = 0; j < 8; ++j) v[j] = xr[k + j] * rstd * g[k + j] * (1.f + sc[k + j]) + sh[k + j];
        st8(h_(p) + (size_t)r * D + k, v); } } };

struct FConv { P p; int l, pad; HD void operator()(long i) const {
    const int r = (int)(i / 1536), ch = (int)(i % 1536); int lo, hi;
    if (r < TL) { lo = (r / S) * S; hi = lo + S; } else { lo = TL + ((r - TL) / LC) * LC; hi = lo + LC; }
    float acc = conv_b_(p)[l * 1536 + ch];
    for (int j = 0; j < 5; ++j) { const int rr = r + j - 2; if (rr >= lo && rr < hi) acc += conv_w_(p)[(l * 5 + j) * 1536 + ch] * bf2f(proj_(p)[(size_t)rr * NPROJ + PC_XBC + ch]); }
    xa_(p)[(size_t)r * 1536 + ch] = f2bf(siluf_(acc)); } };

struct FRouterT { P p; HD void operator()(long i) const {
    const int k = (int)(i % D), e = (int)((i / D) % NE), l = (int)(i / ((long)D * NE)); router_wT_(p)[i] = p.small_in[WS_router_w - WS_SMALL0][((size_t)l * D + k) * NE + e]; } };
struct FConv8 { P p; int l, pad; HD void operator()(long i) const {
    const int r = (int)(i / 192), ch = (int)(i % 192) * 8; int lo, hi;
    if (r < TL) { lo = (r / S) * S; hi = lo + S; } else { lo = TL + ((r - TL) / LC) * LC; hi = lo + LC; }
    float acc[8];
    for (int q = 0; q < 8; ++q) acc[q] = conv_b_(p)[l * 1536 + ch + q];
    for (int j = 0; j < 5; ++j) { const int rr = r + j - 2; if (rr >= lo && rr < hi) { float xv[8]; ld8(proj_(p) + (size_t)rr * NPROJ + PC_XBC + ch, xv); const float* w = conv_w_(p) + (l * 5 + j) * 1536 + ch;
            for (int q = 0; q < 8; ++q) acc[q] += w[q] * xv[q]; } }
    for (int q = 0; q < 8; ++q) acc[q] = siluf_(acc[q]);
    st8(xa_(p) + (size_t)r * 1536 + ch, acc); } };
struct FRopeTab { P p; HD void operator()(long i) const {
    const int i16 = (int)(i & 15), pos = (int)(i >> 4); const float inv = expf(-(float)(2 * i16) * (1.f / 32.f) * 9.210340371976184f), ang = (float)pos * inv;
    rope_tab_(p)[2 * i] = cosf(ang); rope_tab_(p)[2 * i + 1] = sinf(ang); } };
struct FConvBlk { P p; int l, pad; HD void operator()(long i) const {
    const int cg = (int)(i % 192), r0 = (int)(i / 192) * 8, ch = cg * 8; int lo, hi;
    if (r0 < TL) { lo = (r0 / S) * S; hi = lo + S; } else { lo = TL + ((r0 - TL) / LC) * LC; hi = lo + LC; }
    uint4 xr[12];
#pragma unroll
    for (int k = 0; k < 12; ++k) { const int rr = r0 + k - 2; const int rc = rr < lo ? lo : (rr >= hi ? hi - 1 : rr); xr[k] = *(const uint4*)(proj_(p) + (size_t)rc * NPROJ + PC_XBC + ch); }
    float w[5][8], bs[8];
#pragma unroll
    for (int j = 0; j < 5; ++j)
#pragma unroll
        for (int q = 0; q < 8; ++q) w[j][q] = conv_w_(p)[(l * 5 + j) * 1536 + ch + q];
#pragma unroll
    for (int q = 0; q < 8; ++q) bs[q] = conv_b_(p)[l * 1536 + ch + q];
    float xf[12][8];
#pragma unroll
    for (int k = 0; k < 12; ++k) { const int rr = r0 + k - 2; const bool ok = rr >= lo && rr < hi; const unsigned wd[4] = {xr[k].x, xr[k].y, xr[k].z, xr[k].w};
#pragma unroll
        for (int q = 0; q < 8; ++q) xf[k][q] = ok ? u2f((q & 1) ? (wd[q >> 1] & 0xffff0000u) : (wd[q >> 1] << 16)) : 0.f; }
#pragma unroll
    for (int o = 0; o < 8; ++o) { float acc[8];
#pragma unroll
        for (int q = 0; q < 8; ++q) { float a = bs[q];
#pragma unroll
            for (int j = 0; j < 5; ++j) a += w[j][q] * xf[o + j][q];
            acc[q] = siluf_(a); }
        st8(xa_(p) + (size_t)(r0 + o) * 1536 + ch, acc); } } };
struct FRope { P p; HD void operator()(long i) const {
    const int hf = (int)(i & 1); const long q = i >> 1; const int j = (int)(q % 10), r = (int)(q / 10);
    const int s = r % S, pos = hf == 0 ? s / GW : s % GW; const float* tb = rope_tab_(p) + pos * 32;
    const bf16* src; bf16* dst;
    if (j < 8) { src = proj_(p) + (size_t)r * NPROJ + PC_QS + j * 64 + hf * 32; dst = qsr_(p) + (size_t)r * 512 + j * 64 + hf * 32; }
    else { src = proj_(p) + (size_t)r * NPROJ + PC_KS + (j - 8) * 64 + hf * 32; dst = ksr_(p) + (size_t)r * 128 + (j - 8) * 64 + hf * 32; }
    float u1[16], u2[16], o1[16], o2[16]; ld8(src, u1); ld8(src + 8, u1 + 8); ld8(src + 16, u2); ld8(src + 24, u2 + 8);
#pragma unroll
    for (int k = 0; k < 16; ++k) { const float cs = tb[2 * k], sn = tb[2 * k + 1]; o1[k] = u1[k] * cs - u2[k] * sn; o2[k] = u2[k] * cs + u1[k] * sn; }
    st8(dst, o1); st8(dst + 8, o1 + 8); st8(dst + 16, o2); st8(dst + 24, o2 + 8); } };

struct FScan { P p; int l, pad; HD void operator()(long i) const {
    const int pp = (int)(i & 63), dir = (int)((i >> 6) & 1), hh = (int)((i >> 7) & 15), b = (int)(i >> 11);
    const float A = -expf(a_log_(p)[(l * 2 + dir) * 16 + hh]), bias = dt_bias_(p)[(l * 2 + dir) * 16 + hh]; const int g = hh >> 3;
    float st[128];
#pragma unroll
    for (int n = 0; n < 128; ++n) st[n] = 0.f;
    float* yo = dir ? yb_(p) : yf_(p);
    for (int step = 0; step < LC + S; ++step) {
        int r;
        if (dir == 0) r = step < LC ? TL + b * LC + step : b * S + (step - LC);
        else r = step < LC ? TL + b * LC + (LC - 1 - step) : b * S + (S - 1 - (step - LC));
        const float dtv = softplusf_(dt_(p)[(size_t)r * 32 + dir * 16 + hh] + bias), a = expf(dtv * A), xv = bf2f(xa_(p)[(size_t)r * 1536 + hh * 64 + pp]) * dtv;
        const bf16* Bp = xa_(p) + (size_t)r * 1536 + 1024 + g * 128; const bf16* Cp = Bp + 256; float y = 0.f;
#pragma unroll
        for (int n = 0; n < 128; n += 8) { float bv[8], cv[8]; ld8(Bp + n, bv); ld8(Cp + n, cv);
#pragma unroll
            for (int j = 0; j < 8; ++j) { st[n + j] = a * st[n + j] + xv * bv[j]; y += st[n + j] * cv[j]; } }
        yo[(size_t)r * 1024 + hh * 64 + pp] = y; } } };

struct FSsdOut { P p; int l, pad; HD void operator()(long i) const {
    const int r = (int)i; float ss = 0.f;
    for (int ch = 0; ch < 1024; ++ch) { const float y = (yf_(p)[(size_t)r * 1024 + ch] + yb_(p)[(size_t)r * 1024 + ch] + ssd_d_(p)[l * 16 + (ch >> 6)] * bf2f(xa_(p)[(size_t)r * 1536 + ch])) * siluf_(bf2f(proj_(p)[(size_t)r * NPROJ + PC_Z + ch])); ss += y * y; }
    const float rstd = 1.f / sqrtf(ss * (1.f / 1024.f) + NORM_EPS);
    for (int ch = 0; ch < 1024; ++ch) { const float y = (yf_(p)[(size_t)r * 1024 + ch] + yb_(p)[(size_t)r * 1024 + ch] + ssd_d_(p)[l * 16 + (ch >> 6)] * bf2f(xa_(p)[(size_t)r * 1536 + ch])) * siluf_(bf2f(proj_(p)[(size_t)r * NPROJ + PC_Z + ch]));
        ossd_(p)[(size_t)r * 1024 + ch] = f2bf(y * rstd * ssd_norm_g_(p)[l * 1024 + ch]); } } };

#define ATT_KEY(kptr, vptr, extra) do { float sc_ = 0.f; \
    _Pragma("unroll") for (int d_ = 0; d_ < 64; d_ += 8) { float kv_[8]; ld8((kptr) + d_, kv_); _Pragma("unroll") for (int j_ = 0; j_ < 8; ++j_) sc_ += q[d_ + j_] * kv_[j_]; } \
    sc_ = sc_ * 0.125f + (extra); const float mn_ = sc_ > mx ? sc_ : mx; const float cf_ = expf(mx - mn_), pe_ = expf(sc_ - mn_); den = den * cf_ + pe_; mx = mn_; \
    _Pragma("unroll") for (int d_ = 0; d_ < 64; d_ += 8) { float vv_[8]; ld8((vptr) + d_, vv_); _Pragma("unroll") for (int j_ = 0; j_ < 8; ++j_) o[d_ + j_] = o[d_ + j_] * cf_ + pe_ * vv_[j_]; } } while (0)

struct FSwa { P p; int l, pad; HD void operator()(long i) const {
    const int hq = (int)(i & 7), r = (int)(i >> 3), kvh = hq >> 2; const float sink = swa_sink_(p)[l * 8 + hq];
    float q[64], o[64]; float mx = sink, den = 1.f;
#pragma unroll
    for (int d = 0; d < 64; ++d) o[d] = 0.f;
    int b;
    if (r < TL) { b = r / S; const int s = r % S;
#pragma unroll
        for (int d = 0; d < 64; d += 8) ld8(qsr_(p) + (size_t)r * 512 + hq * 64 + d, q + d);
        const int j0 = s - 128 < 0 ? 0 : s - 128, j1 = s + 128 > S - 1 ? S - 1 : s + 128;
        for (int j = j0; j <= j1; ++j) { const size_t rr = (size_t)b * S + j; ATT_KEY(ksr_(p) + rr * 128 + kvh * 64, proj_(p) + rr * NPROJ + PC_VS + kvh * 64, 0.f); }
    } else { b = (r - TL) / LC;
#pragma unroll
        for (int d = 0; d < 64; d += 8) ld8(proj_(p) + (size_t)r * NPROJ + PC_QS + hq * 64 + d, q + d); }
    for (int cj = 0; cj < LC; ++cj) { const size_t rr = (size_t)TL + (size_t)b * LC + cj; ATT_KEY(proj_(p) + rr * NPROJ + PC_KS + kvh * 64, proj_(p) + rr * NPROJ + PC_VS + kvh * 64, 0.f); }
    const float inv = 1.f / den;
#pragma unroll
    for (int d = 0; d < 64; d += 8) { float v[8];
#pragma unroll
        for (int j = 0; j < 8; ++j) v[j] = o[d + j] * inv;
        st8(oswa_(p) + (size_t)r * 512 + hq * 64 + d, v); } } };

struct FNa { P p; int l, pad; HD void operator()(long i) const {
    const int hh = (int)(i & 7), r = (int)(i >> 3);
    float q[64], o[64]; float mx = -1e30f, den = 0.f;
#pragma unroll
    for (int d = 0; d < 64; ++d) o[d] = 0.f;
#pragma unroll
    for (int d = 0; d < 64; d += 8) ld8(proj_(p) + (size_t)r * NPROJ + PC_QN + hh * 64 + d, q + d);
    int b;
    if (r < TL) { b = r / S; const int s = r % S, qr = s / GW, qc = s % GW;
        int r0 = qr - 4; r0 = r0 < 0 ? 0 : (r0 > 24 ? 24 : r0); int c0 = qc - 8; c0 = c0 < 0 ? 0 : (c0 > 48 ? 48 : c0);
        const float* rpb = na_rpb_(p) + (size_t)(l * 8 + hh) * 15 * 31;
        for (int kr = r0; kr < r0 + 8; ++kr) for (int kc = c0; kc < c0 + 16; ++kc) { const size_t rr = (size_t)b * S + kr * GW + kc;
            const float bias = rpb[(kr - qr + 7) * 31 + (kc - qc + 15)];
            ATT_KEY(proj_(p) + rr * NPROJ + PC_KN + hh * 64, proj_(p) + rr * NPROJ + PC_VN + hh * 64, bias); }
    } else b = (r - TL) / LC;
    for (int cj = 0; cj < LC; ++cj) { const size_t rr = (size_t)TL + (size_t)b * LC + cj; ATT_KEY(proj_(p) + rr * NPROJ + PC_KN + hh * 64, proj_(p) + rr * NPROJ + PC_VN + hh * 64, 0.f); }
    const float inv = 1.f / den;
#pragma unroll
    for (int d = 0; d < 64; d += 8) { float v[8];
#pragma unroll
        for (int j = 0; j < 8; ++j) v[j] = o[d + j] * inv;
        st8(ona_(p) + (size_t)r * 512 + hh * 64 + d, v); } } };

struct FNorm2 { P p; int l, pad; HD void operator()(long i) const {
    const int r = (int)i; const float* xr = xl_(p) + (size_t)r * D; float ss = 0.f;
    for (int k = 0; k < D; ++k) ss += xr[k] * xr[k];
    const float rstd = 1.f / sqrtf(ss * (1.f / D) + NORM_EPS);
    const float* sh = mod_ptr(p, l, r, 3); const float* sc = mod_ptr(p, l, r, 4); const float* g = norm2_g_(p) + (size_t)l * D; const float* rw = router_w_(p) + (size_t)l * D * NE;
    float lg[NE];
#pragma unroll
    for (int e = 0; e < NE; ++e) lg[e] = router_b_(p)[l * NE + e];
    for (int k = 0; k < D; k += 8) { float v[8];
        for (int j = 0; j < 8; ++j) { v[j] = xr[k + j] * rstd * g[k + j] * (1.f + sc[k + j]) + sh[k + j]; const float* w = rw + (size_t)(k + j) * NE;
#pragma unroll
            for (int e = 0; e < NE; ++e) lg[e] += v[j] * w[e]; }
        st8(h_(p) + (size_t)r * D + k, v); }
    float tv[4]; int ti[4];
#pragma unroll
    for (int j = 0; j < 4; ++j) { float best = -3e38f; int bi = 0;
#pragma unroll
        for (int e = 0; e < NE; ++e) if (lg[e] > best) { best = lg[e]; bi = e; }
#pragma unroll
        for (int e = 0; e < NE; ++e) if (e == bi) lg[e] = -3e38f;
        tv[j] = best; ti[j] = bi; }
    const float e1 = expf(tv[1] - tv[0]), e2 = expf(tv[2] - tv[0]), e3 = expf(tv[3] - tv[0]), inv = 1.f / (1.f + e1 + e2 + e3);
    topw_(p)[r * 4 + 0] = inv; topw_(p)[r * 4 + 1] = e1 * inv; topw_(p)[r * 4 + 2] = e2 * inv; topw_(p)[r * 4 + 3] = e3 * inv;
#pragma unroll
    for (int j = 0; j < 4; ++j) { topi_(p)[r * 4 + j] = ti[j]; atomic_add_i(cnt_(p) + ti[j], 1); } } };

struct FPlan { P p; HD void operator()(long) const {
    int tot = 0, n1 = 0, n2 = 0;
    for (int e = 0; e < NE; ++e) { const int c = cnt_(p)[e], nt = (c + 255) >> 8; pstart_(p)[e] = tot;
        for (int rt = 0; rt < nt; ++rt) { const int pm = (tot >> 8) + rt;
            for (int j = 0; j < 8; ++j) units1_(p)[n1++] = (pm << 16) | (e * 8 + j);
            for (int j = 0; j < 4; ++j) units2_(p)[n2++] = (pm << 16) | (e * 4 + j); }
        tot += nt << 8; }
    pstart_(p)[NE] = tot; nunits_(p)[0] = n1; nunits_(p)[1] = n2; } };
struct FSlotInit { P p; HD void operator()(long i) const { slot_tok_(p)[i] = -1; } };
struct FAssign { P p; HD void operator()(long i) const {
    const int e = topi_(p)[i], pos = atomic_add_i(cursor_(p) + e, 1), slot = pstart_(p)[e] + pos; slot_of_(p)[i] = slot; slot_tok_(p)[slot] = (int)(i >> 2); } };
struct FGather { P p; HD void operator()(long i) const {
    const int slot = (int)(i >> 7), c8 = (int)(i & 127) * 8; if (slot >= pstart_(p)[NE]) return; const int t = slot_tok_(p)[slot];
    uint4 v; v.x = v.y = v.z = v.w = 0u; if (t >= 0) v = *(const uint4*)(h_(p) + (size_t)t * D + c8); *(uint4*)(xs_(p) + (size_t)slot * D + c8) = v; } };

struct FFinal { P p; HD void operator()(long i) const {
    const int r = (int)i; moe_combine_row(p, NL - 1, r);
    const float* xr = xl_(p) + (size_t)r * D; float ss = 0.f;
    for (int k = 0; k < D; ++k) ss += xr[k] * xr[k];
    const float rstd = 1.f / sqrtf(ss * (1.f / D) + NORM_EPS);
    for (int k = 0; k < D; ++k) p.out[(size_t)r * D + k] = xr[k] * rstd * final_g_(p)[k]; } };

HD float swiglu_(float g, float u) { g = g < 7.f ? g : 7.f; u = u < -7.f ? -7.f : (u > 7.f ? 7.f : u); return (u + 1.f) * g * sigmoidf_(1.702f * g); }

#ifdef HOST_EMU
#define FWD_ATTR static
#define LAUNDER(x)
#else
#define LAUNDER(x) do { size_t z_ = 0; asm volatile("" : "+s"(z_)); (x) = p0.ws + z_; } while (0)
#define FWD_ATTR __device__ __forceinline__
#endif
template <class Ex> FWD_ATTR void forward(Ex& ex, const P& p0) {
    P p = p0;
    ex.ph_prologue(p);
    for (int l = 0; l < NL; ++l) {
        LAUNDER(p.ws);
        const bool last = (l == NL - 1); const int rows = last ? TL : TT;
        ex.ph_norm1(p, l, l > 0 ? 1 : 0);
#ifdef PROBE_N1
        ex.ph_norm1(p, l, 0);
#endif
        ex.gemm_win(p, l);
        ex.ph_conv_rope(p, l);
        ex.ph_scan(p, l);
        ex.ph_mixers(p, l, rows);
        ex.gemm_merge(p, l, rows);
        ex.gemm_wout(p, l, rows);
#ifdef PROBE_WOUT
        ex.gemm_wout(p, l, rows, 0.f);
#endif
        ex.ph_norm2(p, l, rows);
#ifdef PROBE_N2
        ex.ph_norm2(p, l, rows, 0);
#endif
        ex.ph_moe_plan(p, l, rows);
        ex.gemm_moe1(p, l);
        ex.gemm_moe2(p, l);
    }
    LAUNDER(p.ws);
    ex.ph_final(p);
}
template <class Ex> struct ItemPhases {
    Ex& self() { return *static_cast<Ex*>(this); }
    void ph_prologue(const P& p) { self().prep_weights(p); self().items(SMALL_FLOATS, FCopySmall{p}); self().items((long)TT * D / 16, FInit{p}); self().items(1024, FRopeTab{p}); self().items((long)NL * 6 * D, FAda{p}); }
    void ph_norm1(const P& p, int l, int combine) { self().items(TT, FNorm1{p, l, combine}); }
    void ph_conv_rope(const P& p, int l) { self().items((long)(TT / 8) * 192, FConvBlk{p, l, 0}); self().items((long)TL * 10 * 2, FRope{p}); }
    void ph_scan(const P& p, int l) { self().items((long)NB * 16 * 2 * 64, FScan{p, l, 0}); }
    void ph_mixers(const P& p, int l, int rows) { self().items(rows, FSsdOut{p, l, 0}); self().items((long)rows * 8, FSwa{p, l, 0}); self().items((long)rows * 8, FNa{p, l, 0}); }
    void ph_norm2(const P& p, int l, int rows, int count = 1) { self().items(rows, FNorm2{p, l, 0}); }
    void ph_moe_plan(const P& p, int l, int rows) { self().items(1, FPlan{p}); self().items(NSLOT, FSlotInit{p}); self().items((long)rows * 4, FAssign{p}); self().items((long)NSLOT * 128, FGather{p}); }
    void ph_final(const P& p) { self().items(TL, FFinal{p}); }
};

#ifndef HOST_EMU
namespace pg8 {
#define PG8_LAS __attribute__((address_space(3)))
typedef unsigned short bf16_t;
typedef short bf16x8 __attribute__((ext_vector_type(8)));
typedef float f32x4 __attribute__((ext_vector_type(4)));
typedef unsigned u32x4 __attribute__((ext_vector_type(4)));
typedef int i32x4 __attribute__((ext_vector_type(4)));
constexpr int BM = 256, BK = 64, HALF = 128, HTB = HALF * BK * 2, STAGE_BYTES = 8 * HTB, NXCD = 8, WGM = 8;
__host__ __device__ __forceinline__ int lds_byte(int r, int c) { const int st = (r >> 4) * 2 + (c >> 5), rr = r & 15, cc = c & 31, ob = rr * 64 + cc * 2; return st * 1024 + (ob ^ (((ob >> 9) & 1) << 5)); }
__host__ __device__ __forceinline__ void stage_rc(int b, int& R, int& C) { const int st = b / 1024, sb = b % 1024, swz = sb ^ (((sb >> 9) & 1) << 5); R = (st >> 1) * 16 + swz / 64; C = (st & 1) * 32 + (swz % 64) / 2; }
__host__ __device__ __forceinline__ int perm32(int rho) { const int n = rho >> 4, i = rho & 15; return 8 * (i >> 2) + 4 * n + (i & 3); }
struct Unit { int pm, pn; };
struct Gemm { const bf16_t* A; const bf16_t* Bt; int M, N, K, pad; };
struct StaticOrder {
    int nM, nN, nwg, G, c;
    __host__ __device__ void init(int M, int N, int G_, int c_) { nM = M / BM; nN = N / BM; nwg = nM * nN; G = G_; c = c_; }
    __host__ __device__ bool next(int i, Unit& u) const {
        const long L = (long)i * G + c; if (L >= nwg) return false;
        int wgid = (int)L; { const int q = nwg / NXCD, r = nwg % NXCD, xcd = wgid % NXCD, off = wgid / NXCD; wgid = (xcd < r ? xcd * (q + 1) : r * (q + 1) + (xcd - r) * q) + off; }
        const int nig = WGM * nN, gid = wgid / nig, fm = gid * WGM, gsz = (nM - fm) < WGM ? (nM - fm) : WGM;
        u.pm = fm + ((wgid % nig) % gsz); u.pn = (wgid % nig) / gsz; return true;
    }
    __device__ __forceinline__ void a_ready(const Unit&) const {}
    __device__ __forceinline__ void done(const Unit&) const {}
};
struct StaticOrderG : StaticOrder { const int* rowmap; __device__ __forceinline__ int rbase(const Unit& u) const { return u.pm * BM; } };
struct WinOrder : StaticOrder {
    __device__ bool next(int i, Unit& u) const { if (!StaticOrder::next(i, u)) return false; if (u.pn == 19) u.pn = 31; return true; } };
struct TableOrder {
    const PG8_LAS int* te; const PG8_LAS int* tb; const int* rowmap; int n, G, c, sh;
    __device__ void bind(int G_, int c_, int nj) { G = G_; c = c_; if (G_ == 256) { const int x = c_ & 7, slot = c_ >> 3, rpx = 32 / nj; c = ((x * rpx + slot / nj) * nj) + slot % nj; } }
    __device__ bool next(int i, Unit& u) const { const long L = (long)i * G + c; if (L >= n) return false; const int pm = (int)L >> sh; u.pm = pm; u.pn = (te[pm] << sh) + ((int)L & ((1 << sh) - 1)); return true; }
    __device__ __forceinline__ int rbase(const Unit& u) const { return tb ? tb[u.pm] : u.pm * BM; }
    __device__ __forceinline__ void a_ready(const Unit&) const {}
    __device__ __forceinline__ void done(const Unit&) const {}
};
__device__ __forceinline__ unsigned cvt_pk_bf16(float lo, float hi) { unsigned r; asm volatile("v_cvt_pk_bf16_f32 %0, %1, %2" : "=v"(r) : "v"(lo), "v"(hi)); return r; }

template <class Epi, class Sched, bool ALIGN_EPI = false, bool SP2 = false, bool GATHER = false, bool FP8 = false, int SCW = 127, int SCX = 127>
__device__ __forceinline__ void gemm_phase(PG8_LAS unsigned char* lds, const Gemm g, const Sched& S, const Epi& E, const int wid_in) {
    unsigned z_ = 0u; asm volatile("" : "+v"(z_)); const int lane_ = (int)__builtin_amdgcn_mbcnt_hi(~0u, __builtin_amdgcn_mbcnt_lo(~0u, z_));
    const int wid = wid_in, tid = wid_in * 64 + lane_, lane = lane_, wr = wid >> 2, wc = wid & 3, fr = lane & 15, fq = lane >> 4;
    const int K = g.K, nt = K / BK;
    static_assert(!GATHER || SP2, "the gathered A path is written for the two-super-phase loop");
    unsigned voffA[2], voffB[2]; unsigned crowo[2][2] = {{0u, 0u}, {0u, 0u}};
#pragma unroll
    for (int i = 0; i < 2; ++i) { int R, C; stage_rc(tid * 16 + i * 8192, R, C); const int Rb = Epi::PERM ? ((R & ~31) + perm32(R & 31)) : R;
        voffA[i] = GATHER ? (unsigned)C * 2u : (unsigned)(R * K + C) * 2u; voffB[i] = (unsigned)(Rb * K + C) * 2u; }
    PG8_LAS unsigned char* glk = lds + 139264 + wid * 1024;
    const size_t kstep = (size_t)(BK * 2);
    const size_t hstep = (size_t)HALF * K * 2;
    const size_t tstep = 2 * hstep;
    const unsigned ldsw = (unsigned)wid * 1024u;
    const int aoff = lds_byte(wr * 64 + fr, fq * 8), boff = lds_byte(wc * 32 + fr, fq * 8);
#define PG8_SA(b, h) (((b) * 2 + (h)) * HTB)
#define PG8_SB(b, h) ((4 + (b) * 2 + (h)) * HTB)
#define PG8_STAGE(bufoff, gbase, voff) do { _Pragma("unroll") for (int _i = 0; _i < 2; ++_i) \
        __builtin_amdgcn_global_load_lds((const unsigned*)((const char*)(gbase) + (voff)[_i]), (PG8_LAS unsigned*)(lds + (bufoff) + ldsw + _i * 8192), 16, 0, 0); } while (0)
#define PG8_STAGE_A(bufoff, NX, koff, h) do { if constexpr (GATHER) { _Pragma("unroll") for (int _i = 0; _i < 2; ++_i) \
        __builtin_amdgcn_global_load_lds((const unsigned*)((const char*)g.A + (size_t)crowo[h][_i] + (koff) + voffA[_i]), (PG8_LAS unsigned*)(lds + (bufoff) + ldsw + _i * 8192), 16, 0, 0); } \
    else { PG8_STAGE(bufoff, ((NX) ? nA : cA) + (size_t)(h) * hstep + (koff), voffA); } } while (0)
#define PG8_LDA(dst, b, h) do { _Pragma("unroll") for (int m = 0; m < 4; ++m) _Pragma("unroll") for (int k = 0; k < 2; ++k) dst[m][k] = *(const PG8_LAS bf16x8*)(lds + PG8_SA(b, h) + aoff + m * 2048 + k * 1024); } while (0)
#define PG8_LDB(dst, b, h) do { _Pragma("unroll") for (int n = 0; n < 2; ++n) _Pragma("unroll") for (int k = 0; k < 2; ++k) dst[n][k] = *(const PG8_LAS bf16x8*)(lds + PG8_SB(b, h) + boff + n * 2048 + k * 1024); } while (0)
#define PG8_CAT(x) __builtin_shufflevector(__builtin_bit_cast(i32x4, (x)[0]), __builtin_bit_cast(i32x4, (x)[1]), 0, 1, 2, 3, 4, 5, 6, 7)
#define PG8_MMA(ai, bj, At, Bt) do { __builtin_amdgcn_s_setprio(1); if constexpr (FP8) { _Pragma("unroll") for (int m = 0; m < 4; ++m) _Pragma("unroll") for (int n = 0; n < 2; ++n) \
        acc[ai][bj][m][n] = __builtin_amdgcn_mfma_scale_f32_16x16x128_f8f6f4(PG8_CAT(Bt[n]), PG8_CAT(At[m]), acc[ai][bj][m][n], 0, 0, 0, SCW, 0, SCX); } \
    else { _Pragma("unroll") for (int m = 0; m < 4; ++m) _Pragma("unroll") for (int n = 0; n < 2; ++n) _Pragma("unroll") for (int k = 0; k < 2; ++k) \
        acc[ai][bj][m][n] = __builtin_amdgcn_mfma_f32_16x16x32_bf16(Bt[n][k], At[m][k], acc[ai][bj][m][n], 0, 0, 0); } __builtin_amdgcn_s_setprio(0); } while (0)
#define PG8_WAIT_V(n) asm volatile("s_waitcnt vmcnt(" #n ")" ::: "memory")
#define PG8_WAIT_L(n) asm volatile("s_waitcnt lgkmcnt(" #n ")" ::: "memory")
#define PG8_BAR __builtin_amdgcn_s_barrier()
#define PG8_SCHED __builtin_amdgcn_sched_barrier(0)
    Unit cur, nxt; int ui = 0;
    if (!S.next(0, cur)) return;
    f32x4 acc[2][2][4][2];
#pragma unroll
    for (int a = 0; a < 2; ++a)
#pragma unroll
        for (int b = 0; b < 2; ++b)
#pragma unroll
            for (int m = 0; m < 4; ++m)
#pragma unroll
                for (int n = 0; n < 2; ++n) acc[a][b][m][n] = (f32x4){0.f, 0.f, 0.f, 0.f};
    bf16x8 At[4][2], B0[2][2], B1[2][2];
    const char* cA = (const char*)g.A + (size_t)cur.pm * tstep; const char* cB = (const char*)g.Bt + (size_t)cur.pn * tstep;
    S.a_ready(cur);
    const char* nA = cA;
    if constexpr (GATHER) {
#pragma unroll
        for (int h = 0; h < 2; ++h)
#pragma unroll
            for (int i = 0; i < 2; ++i) { int R, C; stage_rc(tid * 16 + i * 8192, R, C); crowo[h][i] = (unsigned)S.rowmap[S.rbase(cur) + h * HALF + R] * (unsigned)(K * 2); }
    }
    if constexpr (SP2) {
        PG8_STAGE(PG8_SB(0, 0), cB, voffB); PG8_STAGE(PG8_SB(0, 1), cB + hstep, voffB); PG8_STAGE_A(PG8_SA(0, 0), false, 0, 0); PG8_STAGE_A(PG8_SA(0, 1), false, 0, 1);
        if (wr == 1) PG8_BAR;
        PG8_WAIT_V(2); PG8_BAR;
        PG8_STAGE(PG8_SB(1, 0), cB + kstep, voffB); PG8_STAGE_A(PG8_SA(1, 0), false, kstep, 0); PG8_STAGE(PG8_SB(1, 1), cB + hstep + kstep, voffB);
        PG8_WAIT_V(6); PG8_BAR;
    } else {
        PG8_STAGE(PG8_SB(0, 0), cB, voffB); PG8_STAGE(PG8_SA(0, 0), cA, voffA); PG8_STAGE(PG8_SB(0, 1), cB + hstep, voffB); PG8_STAGE(PG8_SA(0, 1), cA + hstep, voffA);
        if (wr == 1) PG8_BAR;
        PG8_WAIT_V(4); PG8_BAR;
        PG8_STAGE(PG8_SB(1, 0), cB + kstep, voffB); PG8_STAGE(PG8_SA(1, 0), cA + kstep, voffA); PG8_STAGE(PG8_SB(1, 1), cB + hstep + kstep, voffB);
        PG8_WAIT_V(6); PG8_BAR;
    }
    for (;;) {
        const bool has_next = S.next(ui + 1, nxt);
        nA = has_next ? (const char*)g.A + (size_t)nxt.pm * tstep : cA; const char* nB = has_next ? (const char*)g.Bt + (size_t)nxt.pn * tstep : cB;
        if constexpr (GATHER) { if (has_next) {
                unsigned zg_ = 0u; asm volatile("" : "+v"(zg_)); const int tidg = wid * 64 + (int)__builtin_amdgcn_mbcnt_hi(~0u, __builtin_amdgcn_mbcnt_lo(~0u, zg_));
#pragma unroll
                for (int h = 0; h < 2; ++h)
#pragma unroll
                    for (int i = 0; i < 2; ++i) { int R, C; stage_rc(tidg * 16 + i * 8192, R, C); __builtin_amdgcn_global_load_lds((const unsigned*)(S.rowmap + S.rbase(nxt) + h * HALF + R), (PG8_LAS unsigned*)(glk + (h * 2 + i) * 256), 4, 0, 0); } } }
#pragma unroll 1
        for (int t = 0; t < nt; t += 2) {
            const bool last = (t == nt - 2);
            const char* a1 = cA + (size_t)(t + 1) * kstep;
            const char* a2 = last ? nA : cA + (size_t)(t + 2) * kstep; const char* b2 = last ? nB : cB + (size_t)(t + 2) * kstep;
            const char* a3 = a2 + kstep; const char* b3 = b2 + kstep;
            if (last && has_next) S.a_ready(nxt);
            if constexpr (SP2) {
            const size_t k1 = (size_t)(t + 1) * kstep, k2 = last ? (size_t)0 : (size_t)(t + 2) * kstep, k3 = k2 + kstep;
            PG8_LDB(B0, 0, 0); PG8_LDB(B1, 0, 1); PG8_SCHED; PG8_LDA(At, 0, 0); PG8_STAGE_A(PG8_SA(1, 1), false, k1, 1);
            if constexpr (GATHER) { if (last && has_next) {
#pragma unroll
                    for (int h = 0; h < 2; ++h)
#pragma unroll
                        for (int i = 0; i < 2; ++i) crowo[h][i] = *(const PG8_LAS unsigned*)(glk + (h * 2 + i) * 256 + lane * 4) * (unsigned)(K * 2); } }
            PG8_WAIT_V(8); PG8_WAIT_L(0); PG8_BAR; PG8_MMA(0, 0, At, B0); PG8_MMA(0, 1, At, B1); PG8_BAR; PG8_SCHED;
            PG8_LDA(At, 0, 1); PG8_STAGE(PG8_SB(0, 0), b2, voffB); PG8_STAGE(PG8_SB(0, 1), b2 + hstep, voffB); PG8_STAGE_A(PG8_SA(0, 0), last, k2, 0);
            PG8_WAIT_V(8); PG8_WAIT_L(0); PG8_BAR; PG8_MMA(1, 0, At, B0); PG8_MMA(1, 1, At, B1); PG8_BAR; PG8_SCHED;
            PG8_LDB(B0, 1, 0); PG8_LDB(B1, 1, 1); PG8_SCHED; PG8_LDA(At, 1, 0); PG8_STAGE_A(PG8_SA(0, 1), last, k2, 1);
            PG8_WAIT_V(8); PG8_WAIT_L(0); PG8_BAR; PG8_MMA(0, 0, At, B0); PG8_MMA(0, 1, At, B1); PG8_BAR; PG8_SCHED;
            PG8_LDA(At, 1, 1); PG8_STAGE(PG8_SB(1, 0), b3, voffB); PG8_STAGE(PG8_SB(1, 1), b3 + hstep, voffB); PG8_STAGE_A(PG8_SA(1, 0), last, k3, 0);
            PG8_WAIT_V(8); PG8_WAIT_L(0); PG8_BAR; PG8_MMA(1, 0, At, B0); PG8_MMA(1, 1, At, B1); PG8_BAR; PG8_SCHED;
            } else {
            PG8_LDB(B0, 0, 0); PG8_SCHED; PG8_LDA(At, 0, 0); PG8_STAGE(PG8_SA(1, 1), a1 + hstep, voffA);
            PG8_WAIT_L(8); PG8_BAR; PG8_WAIT_L(0); PG8_MMA(0, 0, At, B0); PG8_BAR; PG8_SCHED;
            PG8_LDB(B1, 0, 1); PG8_STAGE(PG8_SB(0, 0), b2, voffB);
            PG8_BAR; PG8_WAIT_L(0); PG8_MMA(0, 1, At, B1); PG8_BAR;
            PG8_LDA(At, 0, 1); PG8_STAGE(PG8_SA(0, 0), a2, voffA);
            PG8_BAR; PG8_WAIT_L(0); PG8_MMA(1, 0, At, B0); PG8_BAR; PG8_SCHED;
            PG8_STAGE(PG8_SB(0, 1), b2 + hstep, voffB);
            PG8_WAIT_V(6); PG8_BAR; PG8_MMA(1, 1, At, B1); PG8_BAR;
            PG8_LDB(B0, 1, 0); PG8_SCHED; PG8_LDA(At, 1, 0); PG8_STAGE(PG8_SA(0, 1), a2 + hstep, voffA);
            PG8_WAIT_L(8); PG8_BAR; PG8_WAIT_L(0); PG8_MMA(0, 0, At, B0); PG8_BAR; PG8_SCHED;
            PG8_LDB(B1, 1, 1); PG8_STAGE(PG8_SB(1, 0), b3, voffB);
            PG8_BAR; PG8_WAIT_L(0); PG8_MMA(0, 1, At, B1); PG8_BAR;
            PG8_LDA(At, 1, 1); PG8_STAGE(PG8_SA(1, 0), a3, voffA);
            PG8_BAR; PG8_WAIT_L(0); PG8_MMA(1, 0, At, B0); PG8_BAR; PG8_SCHED;
            PG8_STAGE(PG8_SB(1, 1), b3 + hstep, voffB);
            PG8_WAIT_V(6); PG8_BAR; PG8_MMA(1, 1, At, B1); PG8_BAR;
            }
        }
        if constexpr (ALIGN_EPI) { if (wr == 0) PG8_BAR; }
        { Unit eu = cur; asm volatile("" : "+v"(eu.pm), "+v"(eu.pn));
          unsigned ze_ = 0u; asm volatile("" : "+v"(ze_)); const int le_ = (int)__builtin_amdgcn_mbcnt_hi(~0u, __builtin_amdgcn_mbcnt_lo(~0u, ze_));
          E(acc, eu, wr, wc, le_ & 15, le_ >> 4); } S.done(cur);
        if (!has_next) break;
#pragma unroll
        for (int a = 0; a < 2; ++a)
#pragma unroll
            for (int b = 0; b < 2; ++b)
#pragma unroll
                for (int m = 0; m < 4; ++m)
#pragma unroll
                    for (int n = 0; n < 2; ++n) acc[a][b][m][n] = (f32x4){0.f, 0.f, 0.f, 0.f};
        cur = nxt; cA = nA; cB = nB; ++ui;
        if constexpr (ALIGN_EPI) { if (wr == 1) PG8_BAR; }
    }
    PG8_WAIT_V(0);
    if constexpr (!ALIGN_EPI) { if (wr == 0) PG8_BAR; }
    PG8_BAR;
#undef PG8_SA
#undef PG8_SB
#undef PG8_STAGE
#undef PG8_STAGE_A
#undef PG8_LDA
#undef PG8_LDB
#undef PG8_MMA
#undef PG8_CAT
#undef PG8_WAIT_V
#undef PG8_WAIT_L
#undef PG8_BAR
#undef PG8_SCHED
}

typedef const f32x4 (&AccRef)[2][2][4][2];
__device__ __forceinline__ u32x4 pack8(const f32x4 a, const f32x4 b) { u32x4 w; w.x = cvt_pk_bf16(a[0], a[1]); w.y = cvt_pk_bf16(a[2], a[3]); w.z = cvt_pk_bf16(b[0], b[1]); w.w = cvt_pk_bf16(b[2], b[3]); return w; }
__device__ __forceinline__ void unpack8(const u32x4 w, f32x4& a, f32x4& b) {
    a[0] = __uint_as_float(w.x << 16); a[1] = __uint_as_float(w.x & 0xffff0000u); a[2] = __uint_as_float(w.y << 16); a[3] = __uint_as_float(w.y & 0xffff0000u);
    b[0] = __uint_as_float(w.z << 16); b[1] = __uint_as_float(w.z & 0xffff0000u); b[2] = __uint_as_float(w.w << 16); b[3] = __uint_as_float(w.w & 0xffff0000u); }
__device__ __forceinline__ f32x4 sig4(const f32x4 x) { f32x4 r; for (int j = 0; j < 4; ++j) r[j] = sigmoidf_(x[j]); return r; }

struct EpiWin {
    static constexpr bool PERM = true, AFTER_DRAIN = false;
    bf16_t* proj; float* dt; int pn_off, pad;
    __device__ __forceinline__ void operator()(AccRef acc, const Unit& u0, int wr, int wc, int fr, int fq) const {
        Unit u = u0; u.pn = u0.pn + pn_off;
        const int row0 = u.pm * BM + wr * 64 + fr;
        if (u.pn < 31) { const int col0 = u.pn * BM + wc * 32 + 8 * fq;
#pragma unroll
            for (int ai = 0; ai < 2; ++ai)
#pragma unroll
                for (int m = 0; m < 4; ++m) { bf16_t* rowp = proj + (size_t)(row0 + ai * HALF + m * 16) * NPROJ + col0;
#pragma unroll
                    for (int bj = 0; bj < 2; ++bj) *(u32x4*)(rowp + bj * HALF) = pack8(acc[ai][bj][m][0], acc[ai][bj][m][1]); }
        } else if (wc == 0) {
#pragma unroll
            for (int ai = 0; ai < 2; ++ai)
#pragma unroll
                for (int m = 0; m < 4; ++m) { float* rowp = dt + (size_t)(row0 + ai * HALF + m * 16) * 32 + 8 * fq;
                    *(f32x4*)rowp = acc[ai][0][m][0]; *(f32x4*)(rowp + 4) = acc[ai][0][m][1]; }
        }
    }
};
struct EpiGate {
    static constexpr bool PERM = true, AFTER_DRAIN = false;
    unsigned char* g8; const float* bg;
    __device__ __forceinline__ void operator()(AccRef acc, const Unit& u, int wr, int wc, int fr, int fq) const {
        const int row0 = u.pm * BM + wr * 64 + fr, col0 = u.pn * BM + wc * 32 + 8 * fq;
#pragma unroll
        for (int bj = 0; bj < 2; ++bj) { const f32x4 b0 = *(const f32x4*)(bg + col0 + bj * HALF), b1 = *(const f32x4*)(bg + col0 + bj * HALF + 4);
#pragma unroll
            for (int ai = 0; ai < 2; ++ai)
#pragma unroll
                for (int m = 0; m < 4; ++m) { const f32x4 s0 = sig4(acc[ai][bj][m][0] + b0), s1 = sig4(acc[ai][bj][m][1] + b1); unsigned lo = 0u, hi = 0u;
#pragma unroll
                    for (int j = 0; j < 4; ++j) { lo |= (unsigned)(s0[j] * 255.f + 0.5f) << (8 * j); hi |= (unsigned)(s1[j] * 255.f + 0.5f) << (8 * j); }
                    *(uint2*)(g8 + (size_t)(row0 + ai * HALF + m * 16) * 3072 + col0 + bj * HALF) = uint2{lo, hi}; } }
    }
};
template <int PASS> struct EpiMerge {
    static constexpr bool PERM = true, AFTER_DRAIN = false;
    const unsigned char* gsrc; const float* bg; float* macc; bf16_t* mo; const float* ssq;
    __device__ __forceinline__ void operator()(AccRef acc, const Unit& u, int wr, int wc, int fr, int fq) const {
        const int row0 = u.pm * BM + wr * 64 + fr, col0 = u.pn * BM + wc * 32 + 8 * fq, lane = fq * 16 + fr;
#pragma unroll
        for (int ai = 0; ai < 2; ++ai)
#pragma unroll
            for (int mh = 0; mh < 2; ++mh) { float rs[2] = {1.f, 1.f};
                if (PASS == 0) {
                    f32x4 sv[2][2];
#pragma unroll
                    for (int m2 = 0; m2 < 2; ++m2) { const float* sp = ssq + (size_t)(row0 + ai * HALF + (2 * mh + m2) * 16) * 32 + 8 * fq; sv[m2][0] = *(const f32x4*)sp; sv[m2][1] = *(const f32x4*)(sp + 4); }
#pragma unroll
                    for (int m2 = 0; m2 < 2; ++m2) { float sm = ((sv[m2][0][0] + sv[m2][0][1]) + (sv[m2][0][2] + sv[m2][0][3])) + ((sv[m2][1][0] + sv[m2][1][1]) + (sv[m2][1][2] + sv[m2][1][3]));
                        sm += __int_as_float(__builtin_amdgcn_ds_bpermute((lane ^ 16) << 2, __float_as_int(sm))); sm += __int_as_float(__builtin_amdgcn_ds_bpermute((lane ^ 32) << 2, __float_as_int(sm)));
                        rs[m2] = __builtin_amdgcn_rsqf(sm * (1.f / 1024.f) + NORM_EPS); } }
#pragma unroll
                for (int bj = 0; bj < 2; ++bj) { const int col = col0 + bj * HALF; uint2 gv[2]; u32x4 mq[2]; bf16_t* mb = (bf16_t*)macc;
#pragma unroll
                    for (int m2 = 0; m2 < 2; ++m2) { const size_t row = (size_t)(row0 + ai * HALF + (2 * mh + m2) * 16); gv[m2] = *(const uint2*)(gsrc + row * 3072 + col);
                        if (PASS != 0) mq[m2] = *(const u32x4*)(mb + row * D + col); }
#pragma unroll
                    for (int m2 = 0; m2 < 2; ++m2) { const int m = 2 * mh + m2; const size_t row = (size_t)(row0 + ai * HALF + m * 16); f32x4 g0, g1;
#pragma unroll
                        for (int j = 0; j < 4; ++j) { g0[j] = (float)((gv[m2].x >> (8 * j)) & 0xffu) * (1.f / 255.f); g1[j] = (float)((gv[m2].y >> (8 * j)) & 0xffu) * (1.f / 255.f); }
                        f32x4 v0 = g0 * acc[ai][bj][m][0], v1 = g1 * acc[ai][bj][m][1];
                        if (PASS == 0) *(u32x4*)(mb + row * D + col) = pack8(v0 * rs[m2], v1 * rs[m2]);
                        else { f32x4 a0, a1; unpack8(mq[m2], a0, a1);
                            if (PASS == 1) *(u32x4*)(mb + row * D + col) = pack8(a0 + v0, a1 + v1);
                            else *(u32x4*)(mo + row * D + col) = pack8(v0 + a0, v1 + a1); } } } }
    }
};
struct EpiWout {
    static constexpr bool PERM = true, AFTER_DRAIN = false;
    float* xl; const float* modl; float scale; int pad;
    __device__ __forceinline__ void operator()(AccRef acc, const Unit& u, int wr, int wc, int fr, int fq) const {
        const int row0 = u.pm * BM + wr * 64 + fr, col0 = u.pn * BM + wc * 32 + 8 * fq;
        const int mr = u.pm < TL / BM ? u.pm / (S / BM) : NB; const float* g1 = modl + ((size_t)mr * 6 + 2) * D;
#pragma unroll
        for (int bj = 0; bj < 2; ++bj) { const f32x4 gg0 = *(const f32x4*)(g1 + col0 + bj * HALF) * scale, gg1 = *(const f32x4*)(g1 + col0 + bj * HALF + 4) * scale;
#pragma unroll
            for (int ai = 0; ai < 2; ++ai)
#pragma unroll
                for (int mh = 0; mh < 2; ++mh) { const int col = col0 + bj * HALF; f32x4 xv[2][2];
#pragma unroll
                    for (int m2 = 0; m2 < 2; ++m2) { const bf16_t* xp = (const bf16_t*)xl + (size_t)(row0 + ai * HALF + (2 * mh + m2) * 16) * D + col; unpack8(*(const u32x4*)xp, xv[m2][0], xv[m2][1]); }
#pragma unroll
                    for (int m2 = 0; m2 < 2; ++m2) { const int m = 2 * mh + m2; bf16_t* xp = (bf16_t*)xl + (size_t)(row0 + ai * HALF + m * 16) * D + col;
                        *(u32x4*)xp = pack8(xv[m2][0] + gg0 * acc[ai][bj][m][0], xv[m2][1] + gg1 * acc[ai][bj][m][1]); } } }
    }
};
struct EpiMoe1 {
    static constexpr bool PERM = true, AFTER_DRAIN = false;
    bf16_t* act; const float* b1;
    __device__ __forceinline__ void operator()(AccRef acc, const Unit& u, int wr, int wc, int fr, int fq) const {
        const int row0 = u.pm * BM + wr * 64 + fr, e = u.pn >> 3, j = u.pn & 7, col = j * 128 + wc * 32 + 8 * fq;
        const float* bp = b1 + (size_t)e * 2048 + col; const f32x4 bg0 = *(const f32x4*)bp, bg1 = *(const f32x4*)(bp + 4), bu0 = *(const f32x4*)(bp + 1024), bu1 = *(const f32x4*)(bp + 1028);
#pragma unroll
        for (int ai = 0; ai < 2; ++ai)
#pragma unroll
            for (int m = 0; m < 4; ++m) { const f32x4 g0 = acc[ai][0][m][0] + bg0, g1 = acc[ai][0][m][1] + bg1, u0 = acc[ai][1][m][0] + bu0, u1 = acc[ai][1][m][1] + bu1; f32x4 r0, r1;
#pragma unroll
                for (int q = 0; q < 4; ++q) { r0[q] = swiglu_(g0[q], u0[q]); r1[q] = swiglu_(g1[q], u1[q]); }
                *(u32x4*)(act + (size_t)(row0 + ai * HALF + m * 16) * D + col) = pack8(r0, r1); }
    }
};
struct EpiMoe1F8 {
    static constexpr bool PERM = true, AFTER_DRAIN = false, HOOK = false;
    unsigned char* act8; const float* b1;
    __device__ __forceinline__ void operator()(AccRef acc, const Unit& u, int wr, int wc, int fr, int fq) const {
        const int row0 = u.pm * BM + wr * 64 + fr, e = u.pn >> 3, j = u.pn & 7, col = j * 128 + wc * 32 + 8 * fq;
        const float* bp = b1 + (size_t)e * 2048 + col; const f32x4 bg0 = *(const f32x4*)bp, bg1 = *(const f32x4*)(bp + 4), bu0 = *(const f32x4*)(bp + 1024), bu1 = *(const f32x4*)(bp + 1028);
#pragma unroll
        for (int ai = 0; ai < 2; ++ai)
#pragma unroll
            for (int m = 0; m < 4; ++m) { const f32x4 g0 = acc[ai][0][m][0] + bg0, g1 = acc[ai][0][m][1] + bg1, u0 = acc[ai][1][m][0] + bu0, u1 = acc[ai][1][m][1] + bu1; f32x4 r0, r1;
#pragma unroll
                for (int q = 0; q < 4; ++q) { r0[q] = swiglu_(g0[q], u0[q]) * 4.f; r1[q] = swiglu_(g1[q], u1[q]) * 4.f; }
                int lo = __builtin_amdgcn_cvt_pk_fp8_f32(r0[0], r0[1], 0, false); lo = __builtin_amdgcn_cvt_pk_fp8_f32(r0[2], r0[3], lo, true);
                int hi = __builtin_amdgcn_cvt_pk_fp8_f32(r1[0], r1[1], 0, false); hi = __builtin_amdgcn_cvt_pk_fp8_f32(r1[2], r1[3], hi, true);
                *(uint2*)(act8 + (size_t)(row0 + ai * HALF + m * 16) * D + col) = uint2{(unsigned)lo, (unsigned)hi}; }
    }
};
struct EpiMoe2 {
    static constexpr bool PERM = true, AFTER_DRAIN = false;
    bf16_t* ys; const float* b2;
    __device__ __forceinline__ void operator()(AccRef acc, const Unit& u, int wr, int wc, int fr, int fq) const {
        const int row0 = u.pm * BM + wr * 64 + fr, e = u.pn >> 2, j = u.pn & 3, col0 = j * BM + wc * 32 + 8 * fq;
#pragma unroll
        for (int bj = 0; bj < 2; ++bj) { const int col = col0 + bj * HALF; const float* bp = b2 + (size_t)e * D + col; const f32x4 a0 = *(const f32x4*)bp, a1 = *(const f32x4*)(bp + 4);
#pragma unroll
            for (int ai = 0; ai < 2; ++ai)
#pragma unroll
                for (int m = 0; m < 4; ++m) *(u32x4*)(ys + (size_t)(row0 + ai * HALF + m * 16) * D + col) = pack8(acc[ai][bj][m][0] + a0, acc[ai][bj][m][1] + a1); }
    }
};
}

#define XB_TMO      128
#define XB_XCNT(j)  (256  + 64 * (j))
#define XB_XSUB(j)  (1280 + 64 * (j))
#define XB_XGEN(j)  (2304 + 64 * (j))
#define XB_TOP      3328
#define XB_TOPGEN   3392
#define XCD_BAR_WORDS 3456
#define XB_SPIN_CAP (1u << 18)
#define LAS __attribute__((address_space(3)))
__device__ __forceinline__ unsigned xb_ld(unsigned* p)              { return __hip_atomic_load(p, __ATOMIC_RELAXED, __HIP_MEMORY_SCOPE_AGENT); }
__device__ __forceinline__ unsigned xb_add(unsigned* p, unsigned v) { return __hip_atomic_fetch_add(p, v, __ATOMIC_RELAXED, __HIP_MEMORY_SCOPE_AGENT); }
__device__ __forceinline__ unsigned xb_xcc_id() { return (unsigned)__builtin_amdgcn_s_getreg((3 << 11) | 20) & 0xFu; }
#define XB_SPIN(cond, bar) do { unsigned _sp = 0; while (cond) { __builtin_amdgcn_s_sleep(1); \
    if ((++_sp & 255u) == 0u) { if (xb_ld(&(bar)[XB_TMO])) break; if (_sp > XB_SPIN_CAP) { atomicAdd(&(bar)[XB_TMO], 1u); break; } } } } while (0)
struct XcdBarrier { unsigned* bar; unsigned x; volatile LAS unsigned* st; };
__device__ __forceinline__ XcdBarrier xcd_barrier_post(unsigned* bar, volatile LAS unsigned* st) {
    XcdBarrier b; b.bar = bar; b.x = xb_xcc_id(); b.st = st;
    if (threadIdx.x == 0) (void)xb_add(&bar[XB_XCNT(b.x)], 1u);
    return b;
}
__device__ __forceinline__ void xcd_barrier_complete(unsigned* bar, unsigned x, unsigned& nloc, unsigned& nx) {
    const unsigned G = gridDim.x * gridDim.y * gridDim.z;
    unsigned sum, cnt, mine, sp = 0u;
    for (;;) {
        sum = 0u; cnt = 0u; mine = 0u;
#pragma unroll
        for (unsigned j = 0; j < 16; ++j) { const unsigned c = xb_ld(&bar[XB_XCNT(j)]); sum += c; cnt += (c > 0u) ? 1u : 0u; mine = (j == x) ? c : mine; }
        if (sum == G) break;
        __builtin_amdgcn_s_sleep(1);
        if ((++sp & 255u) == 0u) { if (xb_ld(&bar[XB_TMO])) break; if (sp > XB_SPIN_CAP) { atomicAdd(&bar[XB_TMO], 1u); break; } }
    }
    nloc = mine > 0u ? mine : 1u; nx = cnt > 0u ? cnt : 1u;
}
__device__ __noinline__ void xcd_barrier_impl(unsigned* bar_, unsigned x_, unsigned st_off, unsigned is_leader) {
    XcdBarrier b; b.bar = bar_; b.x = x_; b.st = (volatile LAS unsigned*)st_off;
    asm volatile("s_waitcnt vmcnt(0)" ::: "memory");
    __syncthreads();
    if (is_leader) {
        unsigned* bar = b.bar;
        __builtin_amdgcn_s_waitcnt(0);
        unsigned nloc = b.st[0], nx = b.st[1];
        if (nloc == 0u) { xcd_barrier_complete(bar, b.x, nloc, nx); b.st[0] = nloc; b.st[1] = nx; }
        const unsigned old = xb_add(&bar[XB_XSUB(b.x)], 1u);
        const unsigned gen = old / nloc;
        if (old + 1u == (gen + 1u) * nloc) {
            __builtin_amdgcn_fence(__ATOMIC_RELEASE, "agent");
            asm volatile("s_waitcnt vmcnt(0)" ::: "memory");
            const unsigned og = xb_add(&bar[XB_TOP], 1u);
            const unsigned tg = og / nx;
            if (og + 1u == (tg + 1u) * nx) xb_add(&bar[XB_TOPGEN], 1u);
            else XB_SPIN(xb_ld(&bar[XB_TOPGEN]) == tg, bar);
            __builtin_amdgcn_fence(__ATOMIC_ACQUIRE, "agent");
            xb_add(&bar[XB_XGEN(b.x)], 1u);
            asm volatile("s_waitcnt vmcnt(0)" ::: "memory");
        } else {
            XB_SPIN(xb_ld(&bar[XB_XGEN(b.x)]) == gen, bar);
            __builtin_amdgcn_fence(__ATOMIC_ACQUIRE, "agent");
            asm volatile("s_waitcnt vmcnt(0)" ::: "memory");
        }
    }
    __syncthreads();
}
__device__ __forceinline__ void xcd_barrier(const XcdBarrier& b, unsigned is_leader) { xcd_barrier_impl(b.bar, b.x, (unsigned)(unsigned long)b.st, is_leader); }

#ifndef CAPM_PCT
#define CAPM_PCT 90
#endif
#ifndef CAPW_PCT
#define CAPW_PCT 41
#endif
constexpr int NTHR = 512;
constexpr int LDS_MAIN = 131072, LDS_CTL_OFF = LDS_MAIN, LDS_BYTES = 147456;
struct TDesc { const float* src; bf16* dst; int K, Nsrc, Ndst, map, fp8; };
__device__ __forceinline__ void transpose_item(const TDesc& t, LAS unsigned short* img, int item, int lane) {
    const int nblk = t.Ndst / 64, kb = item / nblk, nb = item % nblk, k0 = 64 * kb, n0 = 64 * nb, c4 = (lane & 15) * 4, kq = lane >> 4;
    const int s0 = t.map == 1 ? win_src(n0 + c4) : (t.map == 2 ? w1_src(n0 + c4) : n0 + c4);
    float4 v[16];
#pragma unroll
    for (int i = 0; i < 16; ++i) v[i] = s0 >= 0 ? *(const float4*)(t.src + (size_t)(k0 + 4 * i + kq) * t.Nsrc + s0) : float4{0.f, 0.f, 0.f, 0.f};
    if (t.fp8) {
        LAS unsigned char* im8 = (LAS unsigned char*)img;
#pragma unroll
        for (int i = 0; i < 16; ++i) { const int a = __builtin_amdgcn_cvt_pk_fp8_f32(v[i].x * 32.f, v[i].y * 32.f, 0, false), b = __builtin_amdgcn_cvt_pk_fp8_f32(v[i].z * 32.f, v[i].w * 32.f, 0, false);
            LAS unsigned char* o = im8 + c4 * 68 + 4 * i + kq; o[0] = (unsigned char)a; o[68] = (unsigned char)(a >> 8); o[136] = (unsigned char)b; o[204] = (unsigned char)(b >> 8); }
        asm volatile("s_waitcnt lgkmcnt(0)" ::: "memory");
        const int c = lane & 3;
#pragma unroll
        for (int j = 0; j < 4; ++j) { const int n = (lane >> 2) + 16 * j; const LAS unsigned* r = (const LAS unsigned*)(im8 + n * 68 + 16 * c);
            uint4 o; o.x = r[0]; o.y = r[1]; o.z = r[2]; o.w = r[3];
            *(uint4*)((unsigned char*)t.dst + (size_t)(n0 + n) * t.K + k0 + 16 * c) = o; }
        asm volatile("s_waitcnt lgkmcnt(0)" ::: "memory");
        return; }
#pragma unroll
    for (int i = 0; i < 16; ++i) { LAS unsigned short* o = img + c4 * 66 + 4 * i + kq; o[0] = f2bf(v[i].x); o[66] = f2bf(v[i].y); o[132] = f2bf(v[i].z); o[198] = f2bf(v[i].w); }
    asm volatile("s_waitcnt lgkmcnt(0)" ::: "memory");
    const int c = lane & 7;
#pragma unroll
    for (int j = 0; j < 8; ++j) { const int n = (lane >> 3) + 8 * j; const LAS unsigned* r = (const LAS unsigned*)(img + n * 66 + 8 * c);
        uint4 o; o.x = r[0]; o.y = r[1]; o.z = r[2]; o.w = r[3];
        *(uint4*)(t.dst + (size_t)(n0 + n) * t.K + k0 + 8 * c) = o; }
    asm volatile("s_waitcnt lgkmcnt(0)" ::: "memory");
}
constexpr int TI_WIN = 16 * 128, TI_SQ = 16 * 16, TI_HALF = 8 * 16, TI_W1 = 16 * 32, TI_LAYER = TI_WIN + TI_SQ + 2 * TI_HALF + TI_SQ + NE * TI_W1 + NE * TI_SQ;
constexpr int TI_NONMOE_G = TI_WIN + TI_SQ + 2 * TI_HALF + TI_SQ;
constexpr int GEMM_WG = 144;
constexpr long TI_ALL = (long)NL * TI_LAYER, CAP_M = (long)TI_LAYER * CAPM_PCT / 100, CAP_W = (long)TI_LAYER * CAPW_PCT / 100;
constexpr long SCH_P0 = TI_ALL - (NL - 1) * (CAP_M + CAP_W) > TI_NONMOE_G ? TI_ALL - (NL - 1) * (CAP_M + CAP_W) : TI_NONMOE_G;
constexpr long sch_merge_lo(int l) { return SCH_P0 + l * (CAP_M + CAP_W) < TI_ALL ? SCH_P0 + l * (CAP_M + CAP_W) : TI_ALL; }
constexpr long sch_wout_lo(int l) { return sch_merge_lo(l) + CAP_M < TI_ALL ? sch_merge_lo(l) + CAP_M : TI_ALL; }
constexpr long sch_wout_hi(int l) { return l == NL - 2 ? TI_ALL : sch_merge_lo(l + 1); }
constexpr bool sch_ok() { for (int l = 0; l + 1 < NL; ++l) { if (sch_wout_hi(l) < (long)(l + 1) * TI_LAYER + TI_NONMOE_G && sch_wout_hi(l) < TI_ALL) return false; if (sch_wout_hi(l) < (long)(l + 1) * TI_LAYER) return false; } return SCH_P0 >= TI_NONMOE_G; }
static_assert(NL < 2 || sch_ok(), "conversion schedule misses a deadline");

__device__ __forceinline__ float xshf(float v, int o, int lane) { return __int_as_float(__builtin_amdgcn_ds_bpermute((lane ^ o) << 2, __float_as_int(v))); }
__device__ __forceinline__ int xshi(int v, int o, int lane) { return __builtin_amdgcn_ds_bpermute((lane ^ o) << 2, v); }
__device__ __forceinline__ float wave_sum(float v, int lane) {
#pragma unroll
    for (int o = 1; o < 64; o <<= 1) v += xshf(v, o, lane);
    return v; }
__device__ __forceinline__ float4 bf4(const uint2 u) { float4 r; r.x = u2f(u.x << 16); r.y = u2f(u.x & 0xffff0000u); r.z = u2f(u.y << 16); r.w = u2f(u.y & 0xffff0000u); return r; }
__device__ __forceinline__ uint2 pk4(const float4 v) { uint2 r; r.x = pk2(v.x, v.y); r.y = pk2(v.z, v.w); return r; }
__device__ __forceinline__ float4 f4mad(const float4 a, const float4 b, const float4 c) { return float4{a.x * b.x + c.x, a.y * b.y + c.y, a.z * b.z + c.z, a.w * b.w + c.w}; }
__device__ __forceinline__ float f4sq(const float4 a) { return (a.x * a.x + a.y * a.y) + (a.z * a.z + a.w * a.w); }

__device__ __forceinline__ void dev_combine(const P& p, int lp, int r, int lane, float4 (&v)[4]) {
    const float* g2 = mod_ptr(p, lp, r, 5); const int* so = slot_of_(p) + r * 4; const float* tw = topw_(p) + r * 4;
    const int q0 = so[0], q1 = so[1], q2 = so[2], q3 = so[3]; const float w0 = tw[0], w1 = tw[1], w2 = tw[2], w3 = tw[3];
    const int s0 = pstart_(p)[q0 >> 20] + (q0 & 0xfffff), s1 = pstart_(p)[q1 >> 20] + (q1 & 0xfffff), s2 = pstart_(p)[q2 >> 20] + (q2 & 0xfffff), s3 = pstart_(p)[q3 >> 20] + (q3 & 0xfffff);
#pragma unroll
    for (int j = 0; j < 4; ++j) { const int idx = (j * 64 + lane) * 4;
        const float4 a = bf4(*(const uint2*)(ys_(p) + (size_t)s0 * D + idx)), b = bf4(*(const uint2*)(ys_(p) + (size_t)s1 * D + idx)), c = bf4(*(const uint2*)(ys_(p) + (size_t)s2 * D + idx)), d = bf4(*(const uint2*)(ys_(p) + (size_t)s3 * D + idx));
        const float4 g = *(const float4*)(g2 + idx);
        v[j].x += g.x * (((w0 * a.x + w1 * b.x) + w2 * c.x) + w3 * d.x); v[j].y += g.y * (((w0 * a.y + w1 * b.y) + w2 * c.y) + w3 * d.y);
        v[j].z += g.z * (((w0 * a.z + w1 * b.z) + w2 * c.z) + w3 * d.z); v[j].w += g.w * (((w0 * a.w + w1 * b.w) + w2 * c.w) + w3 * d.w); } }


namespace att {
typedef short bf16x8 __attribute__((ext_vector_type(8)));
typedef float f32x16 __attribute__((ext_vector_type(16)));
typedef unsigned u32x2 __attribute__((ext_vector_type(2)));
typedef unsigned u32x4 __attribute__((ext_vector_type(4)));
constexpr int VT_RS = 72;
constexpr float LOG2E = 1.4426950408889634f, C2 = 0.125f * LOG2E;
struct State { f32x16 o0, o1; float m, l; };
__device__ __forceinline__ int crow(int r, int hi) { return (r & 3) + 8 * (r >> 2) + 4 * hi; }
__device__ __forceinline__ void load_q(bf16x8 (&qf)[4], const bf16* qp, int qstride, int lane) {
#pragma unroll
    for (int ks = 0; ks < 4; ++ks) qf[ks] = *(const bf16x8*)(qp + (size_t)(lane & 31) * qstride + 16 * ks + 8 * (lane >> 5)); }
__device__ __forceinline__ void load_q_at(bf16x8 (&qf)[4], const bf16* rowp, int lane) {
#pragma unroll
    for (int ks = 0; ks < 4; ++ks) qf[ks] = *(const bf16x8*)(rowp + 16 * ks + 8 * (lane >> 5)); }
struct KV { bf16x8 kf[4]; u32x4 vv[4]; };
__device__ __forceinline__ void load_kv(KV& kv, const bf16* kp, int kstride, const bf16* vp, int vstride, int lane) {
    const int r32 = lane & 31, hi = lane >> 5, quad = lane >> 3, chunk = lane & 7;
#pragma unroll
    for (int ks = 0; ks < 4; ++ks) kv.kf[ks] = *(const bf16x8*)(kp + (size_t)r32 * kstride + 16 * ks + 8 * hi);
#pragma unroll
    for (int i = 0; i < 4; ++i) kv.vv[i] = *(const u32x4*)(vp + (size_t)(4 * quad + i) * vstride + 8 * chunk);
}
template <class MaskF>
__device__ __forceinline__ void compute(State& st, const bf16x8 (&qf)[4], const KV& kv, LAS unsigned char* vt, int lane, MaskF maskf) {
    const int r32 = lane & 31, hi = lane >> 5, quad = lane >> 3, chunk = lane & 7;
#pragma unroll
    for (int dd = 0; dd < 8; ++dd) { const unsigned sel = (dd & 1) ? 0x07060302u : 0x05040100u; u32x2 w;
        w.x = __builtin_amdgcn_perm(kv.vv[1][dd >> 1], kv.vv[0][dd >> 1], sel); w.y = __builtin_amdgcn_perm(kv.vv[3][dd >> 1], kv.vv[2][dd >> 1], sel);
        *(LAS u32x2*)(vt + (8 * chunk + dd) * VT_RS + quad * 8) = w; }
    f32x16 sc, sc2;
#pragma unroll
    for (int r = 0; r < 16; ++r) { sc[r] = 0.f; sc2[r] = 0.f; }
    sc = __builtin_amdgcn_mfma_f32_32x32x16_bf16(kv.kf[0], qf[0], sc, 0, 0, 0); sc2 = __builtin_amdgcn_mfma_f32_32x32x16_bf16(kv.kf[1], qf[1], sc2, 0, 0, 0);
    sc = __builtin_amdgcn_mfma_f32_32x32x16_bf16(kv.kf[2], qf[2], sc, 0, 0, 0); sc2 = __builtin_amdgcn_mfma_f32_32x32x16_bf16(kv.kf[3], qf[3], sc2, 0, 0, 0);
#pragma unroll
    for (int r = 0; r < 16; ++r) sc[r] += sc2[r];
    float mx = -INFINITY;
#pragma unroll
    for (int r = 0; r < 16; ++r) { sc[r] = maskf(r, sc[r]); mx = fmaxf(mx, sc[r]); }
    { const auto sw = __builtin_amdgcn_permlane32_swap(__float_as_uint(mx), __float_as_uint(mx), false, false); mx = fmaxf(__uint_as_float(sw[0]), __uint_as_float(sw[1])); }
    const float mn = fmaxf(st.m, mx * C2);
    if (__builtin_amdgcn_ballot_w64(mn != st.m)) {
        const float alpha = __builtin_amdgcn_exp2f(st.m - mn); st.l *= alpha;
#pragma unroll
        for (int r = 0; r < 16; ++r) { st.o0[r] *= alpha; st.o1[r] *= alpha; }
        st.m = mn; }
    float rs = 0.f;
#pragma unroll
    for (int r = 0; r < 16; ++r) { sc[r] = __builtin_amdgcn_exp2f(__builtin_fmaf(sc[r], C2, -mn)); rs += sc[r]; }
    st.l += rs;
    bf16x8 pb[2];
#pragma unroll
    for (int s2 = 0; s2 < 2; ++s2) { u32x4 w;
        w.x = pg8::cvt_pk_bf16(sc[8 * s2 + 0], sc[8 * s2 + 1]); w.y = pg8::cvt_pk_bf16(sc[8 * s2 + 2], sc[8 * s2 + 3]); w.z = pg8::cvt_pk_bf16(sc[8 * s2 + 4], sc[8 * s2 + 5]); w.w = pg8::cvt_pk_bf16(sc[8 * s2 + 6], sc[8 * s2 + 7]);
        pb[s2] = __builtin_bit_cast(bf16x8, w); }
    asm volatile("s_waitcnt lgkmcnt(0)" ::: "memory");
#pragma unroll
    for (int s2 = 0; s2 < 2; ++s2) {
        const LAS unsigned char* a0 = vt + r32 * VT_RS + (16 * s2 + 4 * hi) * 2;
        u32x4 w0, w1; { const u32x2 x = *(const LAS u32x2*)a0, y = *(const LAS u32x2*)(a0 + 16); w0 = u32x4{x.x, x.y, y.x, y.y}; }
        { const u32x2 x = *(const LAS u32x2*)(a0 + 32 * VT_RS), y = *(const LAS u32x2*)(a0 + 32 * VT_RS + 16); w1 = u32x4{x.x, x.y, y.x, y.y}; }
        st.o0 = __builtin_amdgcn_mfma_f32_32x32x16_bf16(__builtin_bit_cast(bf16x8, w0), pb[s2], st.o0, 0, 0, 0);
        st.o1 = __builtin_amdgcn_mfma_f32_32x32x16_bf16(__builtin_bit_cast(bf16x8, w1), pb[s2], st.o1, 0, 0, 0); }
    asm volatile("s_waitcnt lgkmcnt(0)" ::: "memory");
}
template <class PtrF, class CompF>
__device__ __forceinline__ void run(int n, PtrF ptrf, CompF compf, int lane) {
    KV cur, nxt; { const bf16* kp; const bf16* vp; int ks, vs; ptrf(0, kp, ks, vp, vs); load_kv(cur, kp, ks, vp, vs, lane); }
#pragma unroll 1
    for (int i = 0; i < n; ++i) {
        if (i + 1 < n) { const bf16* kp; const bf16* vp; int ks, vs; ptrf(i + 1, kp, ks, vp, vs); load_kv(nxt, kp, ks, vp, vs, lane); }
        compf(i, cur);
        cur = nxt; }
}
__device__ __forceinline__ void init(State& st, float m0, float l0) {
#pragma unroll
    for (int r = 0; r < 16; ++r) { st.o0[r] = 0.f; st.o1[r] = 0.f; }
    st.m = m0; st.l = l0; }
__device__ __forceinline__ void finish(State& st, bf16* op, int ostride, int lane) {
    const float lt = st.l + xshf(st.l, 32, lane), inv = 1.f / lt; bf16* row = op + (size_t)(lane & 31) * ostride + 4 * (lane >> 5);
#pragma unroll
    for (int g = 0; g < 4; ++g) { u32x2 a, b;
        a.x = pg8::cvt_pk_bf16(st.o0[4 * g] * inv, st.o0[4 * g + 1] * inv); a.y = pg8::cvt_pk_bf16(st.o0[4 * g + 2] * inv, st.o0[4 * g + 3] * inv);
        b.x = pg8::cvt_pk_bf16(st.o1[4 * g] * inv, st.o1[4 * g + 1] * inv); b.y = pg8::cvt_pk_bf16(st.o1[4 * g + 2] * inv, st.o1[4 * g + 3] * inv);
        *(u32x2*)(row + 8 * g) = a; *(u32x2*)(row + 32 + 8 * g) = b; } }
__device__ __forceinline__ void finish_at(State& st, bf16* rowp, int lane) {
    const float lt = st.l + xshf(st.l, 32, lane), inv = 1.f / lt; bf16* row = rowp + 4 * (lane >> 5);
#pragma unroll
    for (int g = 0; g < 4; ++g) { u32x2 a, b;
        a.x = pg8::cvt_pk_bf16(st.o0[4 * g] * inv, st.o0[4 * g + 1] * inv); a.y = pg8::cvt_pk_bf16(st.o0[4 * g + 2] * inv, st.o0[4 * g + 3] * inv);
        b.x = pg8::cvt_pk_bf16(st.o1[4 * g] * inv, st.o1[4 * g + 1] * inv); b.y = pg8::cvt_pk_bf16(st.o1[4 * g + 2] * inv, st.o1[4 * g + 3] * inv);
        *(u32x2*)(row + 8 * g) = a; *(u32x2*)(row + 32 + 8 * g) = b; } }
struct NoMask { __device__ __forceinline__ float operator()(int, float s) const { return s; } };

constexpr int KRS = 144, KMAX = 384, VRS = KMAX * 2 + 24, LB_K = 0, LB_V = KMAX * KRS, LB_RPB = LB_V + 64 * VRS;
static_assert(LB_RPB + 2048 <= 131072, "attention batch LDS map");
template <class PtrF>
__device__ __forceinline__ void stage_batch(LAS unsigned char* lds, int ntiles, PtrF ptrf, unsigned t) {
    u32x4 kreg[6], vreg[2][4]; const int nk = ntiles * 256 - 1, nv = ntiles * 64 - 1;
#pragma unroll
    for (int i = 0; i < 6; ++i) { int id = t + 512 * i; id = id < nk ? id : nk; const int tl = id >> 8, row = (id & 255) >> 3, ch = id & 7; const bf16* kp; const bf16* vp; int ks, vs; ptrf(tl, kp, ks, vp, vs);
        kreg[i] = *(const u32x4*)(kp + (size_t)row * ks + ch * 8); }
#pragma unroll
    for (int j = 0; j < 2; ++j) { int id = t + 512 * j; id = id < nv ? id : nv; const int tl = id >> 6, quad = id & 7, chunk = (id & 63) >> 3; const bf16* kp; const bf16* vp; int ks, vs; ptrf(tl, kp, ks, vp, vs);
#pragma unroll
        for (int q = 0; q < 4; ++q) vreg[j][q] = *(const u32x4*)(vp + (size_t)(4 * quad + q) * vs + 8 * chunk); }
#pragma unroll
    for (int i = 0; i < 6; ++i) { const int id = t + 512 * i; if (id <= nk) { const int tl = id >> 8, row = (id & 255) >> 3, ch = id & 7; *(LAS u32x4*)(lds + LB_K + (tl * 32 + row) * KRS + ch * 16) = kreg[i]; } }
#pragma unroll
    for (int j = 0; j < 2; ++j) { const int id = t + 512 * j; if (id <= nv) { const int tl = id >> 6, quad = id & 7, chunk = (id & 63) >> 3;
#pragma unroll
            for (int dd = 0; dd < 8; ++dd) { const unsigned sel = (dd & 1) ? 0x07060302u : 0x05040100u; u32x2 w;
                w.x = __builtin_amdgcn_perm(vreg[j][1][dd >> 1], vreg[j][0][dd >> 1], sel); w.y = __builtin_amdgcn_perm(vreg[j][3][dd >> 1], vreg[j][2][dd >> 1], sel);
                *(LAS u32x2*)(lds + LB_V + (8 * chunk + dd) * VRS + (tl * 32 + 4 * quad) * 2) = w; } } }
}
template <class MaskF>
__device__ __forceinline__ void compute_lds(State& st, const bf16x8 (&qf)[4], const LAS unsigned char* lds, int koff, int lane, MaskF maskf) {
    const int r32 = lane & 31, hi = lane >> 5;
    f32x16 sc;
#pragma unroll
    for (int r = 0; r < 16; ++r) sc[r] = 0.f;
#pragma unroll
    for (int ks = 0; ks < 4; ++ks) { const bf16x8 kf = *(const LAS bf16x8*)(lds + LB_K + (koff + r32) * KRS + (2 * ks + hi) * 16); sc = __builtin_amdgcn_mfma_f32_32x32x16_bf16(kf, qf[ks], sc, 0, 0, 0); }
    float mx = -INFINITY;
#pragma unroll
    for (int r = 0; r < 16; ++r) { sc[r] = maskf(r, sc[r]); mx = fmaxf(mx, sc[r]); }
    { const auto sw = __builtin_amdgcn_permlane32_swap(__float_as_uint(mx), __float_as_uint(mx), false, false); mx = fmaxf(__uint_as_float(sw[0]), __uint_as_float(sw[1])); }
    const float mn = fmaxf(st.m, mx * C2);
    if (__builtin_amdgcn_ballot_w64(mn != st.m)) {
        const float alpha = __builtin_amdgcn_exp2f(st.m - mn); st.l *= alpha;
#pragma unroll
        for (int r = 0; r < 16; ++r) { st.o0[r] *= alpha; st.o1[r] *= alpha; }
        st.m = mn; }
    float rs = 0.f;
#pragma unroll
    for (int r = 0; r < 16; ++r) { sc[r] = __builtin_amdgcn_exp2f(__builtin_fmaf(sc[r], C2, -mn)); rs += sc[r]; }
    st.l += rs;
#pragma unroll
    for (int s2 = 0; s2 < 2; ++s2) { u32x4 w;
        w.x = pg8::cvt_pk_bf16(sc[8 * s2 + 0], sc[8 * s2 + 1]); w.y = pg8::cvt_pk_bf16(sc[8 * s2 + 2], sc[8 * s2 + 3]); w.z = pg8::cvt_pk_bf16(sc[8 * s2 + 4], sc[8 * s2 + 5]); w.w = pg8::cvt_pk_bf16(sc[8 * s2 + 6], sc[8 * s2 + 7]);
        const bf16x8 pb = __builtin_bit_cast(bf16x8, w);
        const LAS unsigned char* a0 = lds + LB_V + r32 * VRS + (koff + 16 * s2 + 4 * hi) * 2;
        u32x4 w0, w1; { const u32x2 x = *(const LAS u32x2*)a0, y = *(const LAS u32x2*)(a0 + 16); w0 = u32x4{x.x, x.y, y.x, y.y}; }
        { const u32x2 x = *(const LAS u32x2*)(a0 + 32 * VRS), y = *(const LAS u32x2*)(a0 + 32 * VRS + 16); w1 = u32x4{x.x, x.y, y.x, y.y}; }
        st.o0 = __builtin_amdgcn_mfma_f32_32x32x16_bf16(__builtin_bit_cast(bf16x8, w0), pb, st.o0, 0, 0, 0);
        st.o1 = __builtin_amdgcn_mfma_f32_32x32x16_bf16(__builtin_bit_cast(bf16x8, w1), pb, st.o1, 0, 0, 0); }
}
}


namespace ssd {
using att::bf16x8; using att::f32x16; using att::u32x2; using att::u32x4; using att::crow; using att::LOG2E;
constexpr int XRS = 272;
constexpr int L_TAB = 0, L_XT0 = 2048, L_XT1 = L_XT0 + 64 * XRS, L_BT = L_XT1 + 64 * XRS;
__device__ __forceinline__ int chunk_row(int b, int c) { return c < 2 ? TL + b * LC + c * 128 : b * S + (c - 2) * 128; }
template <bool WITH_W> __device__ __forceinline__ void tab_compute(const P& p, int l, int row0, int hh, int dir, int lane, LAS float* tab, LAS float* wtab) {
    {
        const float A = -fexp_(a_log_(p)[(l * 2 + dir) * 16 + hh]) * LOG2E, bias = dt_bias_(p)[(l * 2 + dir) * 16 + hh];
        const float d0 = softplusf_(dt_(p)[(size_t)(row0 + 2 * lane) * 32 + dir * 16 + hh] + bias), d1 = softplusf_(dt_(p)[(size_t)(row0 + 2 * lane + 1) * 32 + dir * 16 + hh] + bias);
        const float a0 = d0 * A, a1 = d1 * A, sm = a0 + a1; float v = sm;
        if (dir == 0) {
#pragma unroll
            for (int o = 1; o < 64; o <<= 1) { const float u = __int_as_float(__builtin_amdgcn_ds_bpermute((lane - o) << 2, __float_as_int(v))); if (lane >= o) v += u; }
            const float ex = v - sm; tab[2 * lane] = ex + a0; tab[2 * lane + 1] = ex + sm;
        } else {
#pragma unroll
            for (int o = 1; o < 64; o <<= 1) { const float u = __int_as_float(__builtin_amdgcn_ds_bpermute((lane + o) << 2, __float_as_int(v))); if (lane + o < 64) v += u; }
            const float ex = v - sm; tab[128 + 2 * lane + 1] = ex + a1; tab[128 + 2 * lane] = ex + sm;
        }
        tab[256 + dir * 128 + 2 * lane] = d0; tab[256 + dir * 128 + 2 * lane + 1] = d1;
        if constexpr (WITH_W) {
#pragma unroll
            for (int ti = 0; ti < 4; ++ti)
#pragma unroll
                for (int j = 0; j < 2; ++j) { const int sidx = lane + 64 * j;
                    if (dir == 0) { if (ti > 0 && sidx < 32 * ti) wtab[ti * 128 + sidx] = __builtin_amdgcn_exp2f(tab[32 * ti - 1] - tab[sidx]) * tab[256 + sidx]; }
                    else { if (ti < 3 && sidx >= 32 * (ti + 1)) wtab[512 + ti * 128 + sidx] = __builtin_amdgcn_exp2f(tab[128 + 32 * (ti + 1)] - tab[128 + sidx]) * tab[384 + sidx]; } } }
    }
}
template <class ScaleF>
__device__ __forceinline__ void stage_T(const bf16* src, int stride, LAS unsigned char* img, int quad, int chunk, ScaleF sc) {
    u32x4 vv[4];
#pragma unroll
    for (int i = 0; i < 4; ++i) vv[i] = *(const u32x4*)(src + (size_t)(4 * quad + i) * stride + 8 * chunk);
    float w[4];
#pragma unroll
    for (int i = 0; i < 4; ++i) w[i] = sc(4 * quad + i);
#pragma unroll
    for (int dd = 0; dd < 8; ++dd) { float f[4];
#pragma unroll
        for (int i = 0; i < 4; ++i) { const unsigned wd = vv[i][dd >> 1]; f[i] = u2f((dd & 1) ? (wd & 0xffff0000u) : (wd << 16)) * w[i]; }
        u32x2 o; o.x = pg8::cvt_pk_bf16(f[0], f[1]); o.y = pg8::cvt_pk_bf16(f[2], f[3]);
        *(LAS u32x2*)(img + (8 * chunk + dd) * XRS + quad * 8) = o; }
}
template <class ScaleF>
__device__ __forceinline__ void stage_T_regs(const u32x4 (&vv)[4], LAS unsigned char* img, int quad, int chunk, ScaleF sc) {
    float w[4];
#pragma unroll
    for (int i = 0; i < 4; ++i) w[i] = sc(4 * quad + i);
#pragma unroll
    for (int dd = 0; dd < 8; ++dd) { float f[4];
#pragma unroll
        for (int i = 0; i < 4; ++i) { const unsigned wd = vv[i][dd >> 1]; f[i] = u2f((dd & 1) ? (wd & 0xffff0000u) : (wd << 16)) * w[i]; }
        u32x2 o; o.x = pg8::cvt_pk_bf16(f[0], f[1]); o.y = pg8::cvt_pk_bf16(f[2], f[3]);
        *(LAS u32x2*)(img + (8 * chunk + dd) * XRS + quad * 8) = o; }
}
}

struct MegaEx {
    LAS unsigned char* lds; XcdBarrier bar;
    __device__ __forceinline__ void sync() { xcd_barrier(bar, tid_() == 0u ? 1u : 0u); }
    int wid;
    __device__ __forceinline__ unsigned tid_() { unsigned z = 0u; asm volatile("" : "+v"(z)); const unsigned ln = __builtin_amdgcn_mbcnt_hi(~0u, __builtin_amdgcn_mbcnt_lo(~0u, z)); unsigned r = (unsigned)wid * 64u + ln; asm volatile("" : "+v"(r)); return r; }
    __device__ __forceinline__ int ssd_unit(int k) const { const int bx = (int)blockIdx.x; return gridDim.x == 256 ? k * 256 + (bx & 7) * 32 + (bx >> 3) : k * (int)gridDim.x + bx; }
    template <class F> __device__ __forceinline__ void items_ns(long n, F f) { const unsigned t = tid_(); for (long i = (long)blockIdx.x * NTHR + t; i < n; i += (long)gridDim.x * NTHR) f(i); }
    template <class F> __device__ __forceinline__ void items(long n, F f) { items_ns(n, f); sync(); }
    template <class Epi> __device__ __forceinline__ void gs(const bf16* A, const bf16* Bt, int M, int N, int K, const Epi& E, int G = 0) {
        pg8::Gemm g{A, Bt, M, N, K, 0}; pg8::StaticOrder S; S.init(M, N, G > 0 ? G : (int)gridDim.x, (int)blockIdx.x);
        if (G > 0 && (int)blockIdx.x >= G) return;
        pg8::gemm_phase<Epi, pg8::StaticOrder, true, true>(lds, g, S, E, wid); }
    static constexpr int L_PLAN = LDS_CTL_OFF + 4096, MAXTILE = NSLOT / 256;
    __device__ __forceinline__ void moe_tables(const P& p) {
        const unsigned t = tid_(); volatile LAS int* ps = (volatile LAS int*)(lds + L_PLAN); volatile LAS int* te = ps + 64; volatile LAS int* tb = te + MAXTILE; volatile LAS int* tmp = tb + MAXTILE;
        static_assert((64 + 2 * MAXTILE + 32) * 4 <= 4096, "plan tables");
        if (t < NE) tmp[t] = ((cursor_(p)[t * 32] + 255) >> 8) << 8;
        __syncthreads();
        if (t == 0) { int tot = 0; for (int e = 0; e < NE; ++e) { ps[e] = tot; tot += tmp[e]; } ps[NE] = tot; }
        __syncthreads();
        const int ntile = ps[NE] >> 8;
        for (int pm = t; pm < ntile; pm += NTHR) { int e = 0;
            for (int k = 1; k < NE; ++k) e += (ps[k] <= pm * 256) ? 1 : 0;
            te[pm] = e; tb[pm] = e * TT + pm * 256 - ps[e]; }
        if (blockIdx.x == 0 && t <= NE) pstart_(p)[t] = ps[t];
        __syncthreads();
    }
    template <bool GATHER, int SCW, int SCX, class Epi> __device__ __forceinline__ void gt(const void* A, const void* Bt, int K, int sh, const int* rowmap, bool sparse, const Epi& E) {
        const LAS int* ps = (const LAS int*)(lds + L_PLAN);
        pg8::Gemm g{(const bf16*)A, (const bf16*)Bt, 0, 0, K, 0}; pg8::TableOrder S; S.te = ps + 64; S.tb = sparse ? ps + 64 + MAXTILE : nullptr; S.rowmap = rowmap; S.sh = sh; S.n = (ps[NE] >> 8) << sh; S.bind((int)gridDim.x, (int)blockIdx.x, 1 << sh);
        pg8::gemm_phase<Epi, pg8::TableOrder, true, true, GATHER, true, SCW, SCX>(lds, g, S, E, wid); }
    static constexpr int TI_NONMOE = TI_WIN + TI_SQ + 2 * TI_HALF + TI_SQ;
    __device__ __forceinline__ void prep_items(const P& p, long glo, long ghi, long gw, long ngw) {
        const unsigned t_ = tid_(); const int lane = t_ & 63, w = t_ >> 6; LAS unsigned short* scr = (LAS unsigned short*)(lds + w * 16384);
        for (long it = glo + gw; it < ghi; it += ngw) { const int l = (int)(it / TI_LAYER); int r = (int)(it - (long)l * TI_LAYER); TDesc t;
            if (r < TI_WIN) { const int nb = r % 128;
                if (nb >= 76 && nb < 124) t = TDesc{p.w_in + (size_t)l * D * 7968, (bf16*)(w_g8_(p) + (size_t)l * 3072 * D - (size_t)4864 * D), D, 7968, NPAD, 1, 1};
                else t = TDesc{p.w_in + (size_t)l * D * 7968, w_in_t_(p) + (size_t)l * NPAD * D, D, 7968, NPAD, 1, 0}; }
            else if ((r -= TI_WIN) < TI_SQ) t = TDesc{p.w_br_ssd + (size_t)l * 1024 * D, w_ssd_t_(p) + (size_t)l * D * 1024, 1024, D, D, 0, 0};
            else if ((r -= TI_SQ) < TI_HALF) t = TDesc{p.w_br_swa + (size_t)l * 512 * D, w_swa_t_(p) + (size_t)l * D * 512, 512, D, D, 0, 0};
            else if ((r -= TI_HALF) < TI_HALF) t = TDesc{p.w_br_na + (size_t)l * 512 * D, w_na_t_(p) + (size_t)l * D * 512, 512, D, D, 0, 0};
            else if ((r -= TI_HALF) < TI_SQ) t = TDesc{p.w_out + (size_t)l * D * D, w_out_t_(p) + (size_t)l * D * D, D, D, D, 0, 0};
            else if ((r -= TI_SQ) < NE * TI_W1) { const int e = r / TI_W1; r %= TI_W1; t = TDesc{p.moe_w1 + ((size_t)l * NE + e) * D * 2048, (bf16*)(w1_8_(p) + ((size_t)l * NE + e) * 2048 * D), D, 2048, 2048, 2, 1}; }
            else { r -= NE * TI_W1; const int e = r / TI_SQ; r %= TI_SQ; t = TDesc{p.moe_w2 + ((size_t)l * NE + e) * D * D, (bf16*)(w2_8_(p) + ((size_t)l * NE + e) * D * D), D, D, D, 0, 1}; }
            transpose_item(t, scr, r, lane);
        }
    }
    __device__ __forceinline__ void prep_weights(const P& p) {
        prep_items(p, 0, gridDim.x == 256 && NL > 1 ? SCH_P0 : TI_ALL, (long)blockIdx.x * 8 + wid, (long)gridDim.x * 8);
    }
    __device__ __forceinline__ bool split_phase(int l, int rows) const { return l + 1 < NL && rows == TT && gridDim.x == 256; }
    __device__ __forceinline__ void prep_side(const P& p, long glo, long ghi) {
        prep_items(p, glo, ghi, (long)(blockIdx.x - GEMM_WG) * 8 + wid, (long)(gridDim.x - GEMM_WG) * 8);
    }
    __device__ __forceinline__ void ph_prologue(const P& p) {
        prep_weights(p);
        items_ns(SMALL_FLOATS, FCopySmall{p});
        items_ns((long)NL * NE * D, FRouterT{p});
        { const unsigned t = tid_(); bf16* xlb = (bf16*)xl_(p);
            for (long i = (long)blockIdx.x * NTHR + t; i < (long)TT * D / 16; i += (long)gridDim.x * NTHR) { const long e = i * 16; const float* src = e < (long)TL * D ? p.x + e : p.ctx + (e - (long)TL * D);
                const float4 a = *(const float4*)src, b = *(const float4*)(src + 4), c = *(const float4*)(src + 8), d = *(const float4*)(src + 12);
                const uint2 pa = pk4(a), pb = pk4(b), pc = pk4(c), pd = pk4(d); *(uint4*)(xlb + e) = uint4{pa.x, pa.y, pb.x, pb.y}; *(uint4*)(xlb + e + 8) = uint4{pc.x, pc.y, pd.x, pd.y}; } }
        items_ns(1024, FRopeTab{p});
        { const unsigned t = tid_(); for (int i = blockIdx.x * NTHR + t; i < NSLOT; i += gridDim.x * NTHR) ident_(p)[i] = i; }
        __syncthreads();
        { const unsigned t = tid_(); LAS float* sc = (LAS float*)lds; LAS float* part = (LAS float*)(lds + 40960);
            for (int i = t; i < 9 * D; i += NTHR) { const int r = i >> 10, k = i & 1023; sc[i] = siluf_(r < NB ? p.c[r * D + k] : p.c_ctx[k]); }
            __syncthreads();
            for (int u = blockIdx.x; u < NL * 6 * D / 128; u += gridDim.x) { const int l = u / 48, col = (u % 48) * 128 + (t & 127), kq = t >> 7;
                const float* w = p.w_ada + (size_t)l * D * 6 * D + col; float acc[9];
#pragma unroll
                for (int r = 0; r < 9; ++r) acc[r] = 0.f;
#pragma unroll 16
                for (int k = kq * 256; k < kq * 256 + 256; ++k) { const float wv = w[(size_t)k * 6 * D];
#pragma unroll
                    for (int r = 0; r < 9; ++r) acc[r] += sc[r * D + k] * wv; }
#pragma unroll
                for (int r = 0; r < 9; ++r) part[(kq * 9 + r) * 128 + (t & 127)] = acc[r];
                __syncthreads();
                for (int i = t; i < 9 * 128; i += NTHR) { const int r = i >> 7, c = i & 127, cc = (u % 48) * 128 + c;
                    mod_(p)[((size_t)(l * (NB + 1) + r)) * 6 * D + cc] = ((part[(0 * 9 + r) * 128 + c] + part[(1 * 9 + r) * 128 + c]) + part[(2 * 9 + r) * 128 + c]) + part[(3 * 9 + r) * 128 + c] + p.b_ada[(size_t)l * 6 * D + cc]; }
                __syncthreads(); } }
        sync();
    }
    __device__ __forceinline__ void ph_norm1(const P& p, int l, int combine) {
        const unsigned t = tid_(); const int lane = t & 63, gw = blockIdx.x * 8 + __builtin_amdgcn_readfirstlane(t >> 6), ngw = gridDim.x * 8;
        if (blockIdx.x == 0 && t < NE) cursor_(p)[t * 32] = 0;
        { int z = 0; asm volatile("" : "+v"(z)); for (int i = blockIdx.x * NTHR + t; i < NE * TT / 4; i += gridDim.x * NTHR) ((int4*)stok2_(p))[i] = int4{z, z, z, z}; }
        if (l == 0) {
            const int gt0 = blockIdx.x * NTHR + t, gstr = gridDim.x * NTHR;
            for (int i = gt0; i < NL * 9 * 1024; i += gstr) { const int k = i & 1023, mr = (i >> 10) % 9, ll = i / (9 * 1024);
                if (mr <= NB) n2_gm_(p)[i] = norm2_g_(p)[ll * D + k] * (1.f + mod_(p)[((size_t)(ll * (NB + 1) + mr) * 6 + 4) * D + k]); }
            for (int i = gw; i < NL * 9 * 32; i += ngw) { const int e = i & 31, mr = (i >> 5) % 9, ll = i / (9 * 32);
                if (mr <= NB) { const float* sh = mod_(p) + ((size_t)(ll * (NB + 1) + mr) * 6 + 3) * D; const float* w = router_w_(p) + (size_t)ll * D * NE + e; float a = 0.f;
#pragma unroll
                    for (int k = 0; k < 16; ++k) a += sh[lane + 64 * k] * w[(size_t)(lane + 64 * k) * NE];
                    a = wave_sum(a, lane);
                    if (lane == 0) n2_c_(p)[i] = a + router_b_(p)[ll * NE + e]; } }
            for (int i = gt0; i < NL * 32 * 2 * 64 * 8; i += gstr) { const int j = i & 7, ln = (i >> 3) & 63, tl = (i >> 9) & 1, sstep = (i >> 10) & 31, ll = i >> 15;
                const float w = router_w_(p)[((size_t)ll * D + 32 * sstep + 8 * (ln >> 4) + j) * NE + 16 * tl + (ln & 15)]; const bf16 hb = f2bf(w);
                n2_wh_(p)[i] = hb; n2_wl_(p)[i] = f2bf(w - bf2f(hb)); } }
        const float* gn = norm1_g_(p) + (size_t)l * D;
        for (int r = gw; r < TT; r += 2 * ngw) { const int rr[2] = {r, r + ngw < TT ? r + ngw : r};
            float4 v[2][4];
#pragma unroll
            for (int q = 0; q < 2; ++q)
#pragma unroll
                for (int j = 0; j < 4; ++j) v[q][j] = bf4(*(const uint2*)((const bf16*)xl_(p) + (size_t)rr[q] * D + (j * 64 + lane) * 4));
            if (combine) {
#pragma unroll
                for (int q = 0; q < 2; ++q) dev_combine(p, l - 1, rr[q], lane, v[q]);
#pragma unroll
                for (int q = 0; q < 2; ++q)
#pragma unroll
                    for (int j = 0; j < 4; ++j) *(uint2*)((bf16*)xl_(p) + (size_t)rr[q] * D + (j * 64 + lane) * 4) = pk4(v[q][j]); }
            float rstd[2];
#pragma unroll
            for (int q = 0; q < 2; ++q) rstd[q] = __builtin_amdgcn_rsqf(wave_sum((f4sq(v[q][0]) + f4sq(v[q][1])) + (f4sq(v[q][2]) + f4sq(v[q][3])), lane) * (1.f / D) + NORM_EPS);
#pragma unroll
            for (int q = 0; q < 2; ++q) { const float* sh = mod_ptr(p, l, rr[q], 0); const float* sc = mod_ptr(p, l, rr[q], 1);
#pragma unroll
                for (int j = 0; j < 4; ++j) { const int idx = (j * 64 + lane) * 4; const float4 g = *(const float4*)(gn + idx), s1 = *(const float4*)(sc + idx), b = *(const float4*)(sh + idx); const float rs = rstd[q];
                    float4 o; o.x = v[q][j].x * rs * g.x * (1.f + s1.x) + b.x; o.y = v[q][j].y * rs * g.y * (1.f + s1.y) + b.y; o.z = v[q][j].z * rs * g.z * (1.f + s1.z) + b.z; o.w = v[q][j].w * rs * g.w * (1.f + s1.w) + b.w;
                    *(uint2*)(h_(p) + (size_t)rr[q] * D + idx) = pk4(o);
                    { int q8 = __builtin_amdgcn_cvt_pk_fp8_f32(o.x, o.y, 0, false); q8 = __builtin_amdgcn_cvt_pk_fp8_f32(o.z, o.w, q8, true); *(int*)(h8n_(p) + (size_t)rr[q] * D + idx) = q8; } } } }
        sync();
    }
    __device__ __forceinline__ void gemm_win(const P& p, int l) {
        { pg8::Gemm g{h_(p), w_in_t_(p) + (size_t)l * NPAD * D, TT, 20 * 256, D, 0}; pg8::WinOrder S; S.init(TT, 20 * 256, (int)gridDim.x, (int)blockIdx.x);
            pg8::gemm_phase<pg8::EpiWin, pg8::WinOrder, true, true>(lds, g, S, pg8::EpiWin{proj_(p), dt_(p), 0, 0}, wid); }
        { pg8::Gemm g{(const bf16*)h8n_(p), (const bf16*)(w_g8_(p) + (size_t)l * 3072 * D), TT, 3072, D / 2, 0}; pg8::StaticOrderG S; S.init(TT, 3072, (int)gridDim.x, (int)gridDim.x - 1 - (int)blockIdx.x); S.rowmap = ident_(p);
            pg8::gemm_phase<pg8::EpiGate, pg8::StaticOrderG, true, true, true, true, 122, 127>(lds, g, S, pg8::EpiGate{gate8_(p), b_gate_(p) + (size_t)l * 3 * D}, wid); }
        sync(); }
    __device__ __forceinline__ void ph_conv_rope(const P& p, int l) {
        items_ns((long)(TT / 8) * 192, FConvBlk{p, l, 0}); items_ns((long)TL * 10 * 2, FRope{p});
        {
            const unsigned t = tid_(); const int lane = t & 63, wv = __builtin_amdgcn_readfirstlane(t >> 6), gw = blockIdx.x * 8 + wv, ngw = gridDim.x * 8;
            LAS float* tab = (LAS float*)(lds + wv * 16384); LAS float* wtab = tab + 512;
#pragma unroll 1
            for (int tk = gw; tk < NB * 18 * 16 * 2; tk += ngw) { const int u = tk >> 1, dir = tk & 1, hh = u & 15, c = (u >> 4) % 18, b = u / (18 * 16), row0 = ssd::chunk_row(b, c);
                ssd::tab_compute<true>(p, l, row0, hh, dir, lane, tab, wtab);
                asm volatile("s_waitcnt lgkmcnt(0)" ::: "memory");
                float* go = sstab_(p) + (size_t)u * 1536;
                go[dir * 128 + lane] = tab[dir * 128 + lane]; go[dir * 128 + 64 + lane] = tab[dir * 128 + 64 + lane];
                go[256 + dir * 128 + lane] = tab[256 + dir * 128 + lane]; go[256 + dir * 128 + 64 + lane] = tab[256 + dir * 128 + 64 + lane];
#pragma unroll
                for (int j = 0; j < 2; ++j) { const pg8::f32x4 wv4 = *(const LAS pg8::f32x4*)(wtab + dir * 512 + (j * 64 + lane) * 4); *(float4*)(go + 512 + dir * 512 + (j * 64 + lane) * 4) = float4{wv4[0], wv4[1], wv4[2], wv4[3]}; }
                asm volatile("s_waitcnt lgkmcnt(0)" ::: "memory"); } }
        sync(); }
    __device__ __forceinline__ void ph_scan(const P& p, int l) {
        using namespace ssd;
        constexpr int L_B0 = 0, L_X0 = 128 * XRS, BUFB = 192 * XRS; static_assert(2 * BUFB <= LDS_MAIN, "S12 LDS map");
        const unsigned t = tid_(); const int lane = t & 63, wv = __builtin_amdgcn_readfirstlane(t >> 6), r32 = lane & 31, hi = lane >> 5, pt = wv >> 2, nt = wv & 3;
        const int qd = t & 31, chb = t >> 5, chx = (t >> 5) & 7;
#pragma unroll 1
        for (int un = blockIdx.x; un < NB * 16 * 2; un += gridDim.x) {
            const int uu = gridDim.x == 256 ? (un & 7) * 32 + (un >> 3) : un, hl = uu & 7, dir = (uu >> 3) & 1, g = (uu >> 4) & 1, b = uu >> 5, hh = g * 8 + hl;
            f32x16 acc;
#pragma unroll
            for (int r = 0; r < 16; ++r) acc[r] = 0.f;
            att::u32x4 vb[4], vx[4]; float4 wcs = float4{0.f, 0.f, 0.f, 0.f}, wdt = wcs; float cl = 0.f;
#define S12_LOAD(s_) do { const int c_ = dir == 0 ? (s_) : ((s_) < 2 ? 1 - (s_) : 19 - (s_)), row0_ = chunk_row(b, c_); const float* tb_ = sstab_(p) + (size_t)((b * 18 + c_) * 16 + hh) * 1536; \
                _Pragma("unroll") for (int i = 0; i < 4; ++i) vb[i] = *(const att::u32x4*)(xa_(p) + (size_t)(row0_ + 4 * qd + i) * 1536 + 1024 + g * 128 + 8 * chb); \
                _Pragma("unroll") for (int i = 0; i < 4; ++i) vx[i] = *(const att::u32x4*)(xa_(p) + (size_t)(row0_ + 4 * qd + i) * 1536 + hh * 64 + 8 * chx); \
                wcs = *(const float4*)(tb_ + dir * 128 + 4 * qd); wdt = *(const float4*)(tb_ + 256 + dir * 128 + 4 * qd); cl = tb_[dir ? 128 : 127]; asm volatile("" ::: "memory"); } while (0)
            S12_LOAD(0);
#pragma unroll 1
            for (int s = 0; s < 18; ++s) { const int c = dir == 0 ? s : (s < 2 ? 1 - s : 19 - s); LAS unsigned char* buf = lds + (s & 1) * BUFB; const float dec = __builtin_amdgcn_exp2f(cl);
                { const float w0 = __builtin_amdgcn_exp2f(cl - wcs.x) * wdt.x, w1 = __builtin_amdgcn_exp2f(cl - wcs.y) * wdt.y, w2 = __builtin_amdgcn_exp2f(cl - wcs.z) * wdt.z, w3 = __builtin_amdgcn_exp2f(cl - wcs.w) * wdt.w;
                    stage_T_regs(vb, buf + L_B0, qd, chb, [](int) { return 1.f; });
                    if (t < 256) stage_T_regs(vx, buf + L_X0, qd, chx, [&](int sidx) { const int j = sidx & 3; return j == 0 ? w0 : (j == 1 ? w1 : (j == 2 ? w2 : w3)); }); }
                __syncthreads();
                if (s + 1 < 18) S12_LOAD(s + 1);
                { bf16* ho = hin_(p) + ((size_t)((b * 18 + c) * 16 + hh) * 2 + dir) * 8192 + 32 * nt + r32;
#pragma unroll
                    for (int r = 0; r < 16; ++r) { ho[(size_t)(32 * pt + crow(r, hi)) * 128] = f2bf(acc[r]); acc[r] *= dec; } }
#pragma unroll
                for (int k = 0; k < 8; ++k) { const bf16x8 a = *(const LAS bf16x8*)(buf + L_X0 + (32 * pt + r32) * XRS + (16 * k + 8 * hi) * 2), bq = *(const LAS bf16x8*)(buf + L_B0 + (32 * nt + r32) * XRS + (16 * k + 8 * hi) * 2);
                    acc = __builtin_amdgcn_mfma_f32_32x32x16_bf16(a, bq, acc, 0, 0, 0); }
            }
            __syncthreads();
        }
#undef S12_LOAD
    }
    __device__ __forceinline__ void scan_s23(const P& p, int l) {
        using namespace ssd;
        {
            constexpr int L_BI = L_XT0 + 64 * XRS, L_CI = L_BI + 128 * XRS, L_HF = L_CI + 128 * XRS, L_HB = L_HF + 64 * XRS;
            static_assert(L_HB + 64 * XRS <= LDS_MAIN, "S3 LDS map");
            const unsigned t = tid_(); const int lane = t & 63, wv = __builtin_amdgcn_readfirstlane(t >> 6), r32 = lane & 31, hi = lane >> 5, ti = wv >> 1, pt = wv & 1;
            LAS float* tab = (LAS float*)(lds + L_TAB); LAS float* wtab = (LAS float*)(lds + 135168);
            att::u32x4 vb[4], vc[4], vh[4], vx[4]; float4 tbv = float4{0.f, 0.f, 0.f, 0.f};
#define S3_LOAD(u_) do { const int t = (int)tid_(); const int hh_ = (u_) & 15, c_ = ((u_) >> 4) % 18, b_ = (u_) / (18 * 16), g_ = hh_ >> 3, row0_ = chunk_row(b_, c_); \
                _Pragma("unroll") for (int i = 0; i < 4; ++i) { const int id = t + 512 * i, row = id >> 4, ch = id & 15; const bf16* src = xa_(p) + (size_t)(row0_ + row) * 1536 + 1024 + g_ * 128 + ch * 8; \
                    vb[i] = *(const att::u32x4*)src; vc[i] = *(const att::u32x4*)(src + 256); } \
                _Pragma("unroll") for (int i = 0; i < 4; ++i) { const int id = t + 512 * (i & 1), row = id >> 4, ch = id & 15; vh[i] = *(const att::u32x4*)(hin_(p) + ((size_t)(u_) * 2 + (i >> 1)) * 8192 + row * 128 + ch * 8); } \
                if (t < 384) tbv = *(const float4*)(sstab_(p) + (size_t)(u_) * 1536 + 4 * t); \
                if (t < 256) { _Pragma("unroll") for (int i = 0; i < 4; ++i) vx[i] = *(const att::u32x4*)(xa_(p) + (size_t)(row0_ + 4 * (t >> 3) + i) * 1536 + hh_ * 64 + 8 * (t & 7)); } \
                asm volatile("" ::: "memory"); } while (0)
            if (ssd_unit(0) < NB * 18 * 16) S3_LOAD(ssd_unit(0));
            for (int k = 0, u; (u = ssd_unit(k)) < NB * 18 * 16; ++k) { const int hh = u & 15, c = (u >> 4) % 18, b = u / (18 * 16), row0 = chunk_row(b, c);
                {
                    const int t = (int)tid_();
                    if (t < 256) stage_T_regs(vx, lds + L_XT0, t >> 3, t & 7, [](int) { return 1.f; });
                    if (t < 128) *(LAS pg8::f32x4*)(tab + 4 * t) = pg8::f32x4{tbv.x, tbv.y, tbv.z, tbv.w}; else if (t < 384) *(LAS pg8::f32x4*)(wtab + 4 * (t - 128)) = pg8::f32x4{tbv.x, tbv.y, tbv.z, tbv.w};
#pragma unroll
                    for (int i = 0; i < 4; ++i) { const int id = t + 512 * i, row = id >> 4, ch = id & 15; *(LAS att::u32x4*)(lds + L_BI + row * XRS + ch * 16) = vb[i]; *(LAS att::u32x4*)(lds + L_CI + row * XRS + ch * 16) = vc[i]; }
#pragma unroll
                    for (int i = 0; i < 4; ++i) { const int id = t + 512 * (i & 1), row = id >> 4, ch = id & 15; *(LAS att::u32x4*)(lds + ((i >> 1) ? L_HB : L_HF) + row * XRS + ch * 16) = vh[i]; }
                }
                __syncthreads();
                { const int un = ssd_unit(k + 1); if (un < NB * 18 * 16) S3_LOAD(un); }
                const int tt = 32 * ti + r32; const float csf_t = tab[tt], cbb_t = tab[128 + tt];
                uint2 xq[4], zq[4];
#pragma unroll
                for (int gq = 0; gq < 4; ++gq) { const int ch = hh * 64 + 32 * pt + 4 * hi + 8 * gq; xq[gq] = *(const uint2*)(xa_(p) + (size_t)(row0 + tt) * 1536 + ch); zq[gq] = *(const uint2*)(proj_(p) + (size_t)(row0 + tt) * NPROJ + PC_Z + ch); }
                const float ef_t = ti > 0 ? __builtin_amdgcn_exp2f(csf_t - tab[32 * ti - 1]) : 0.f, eb_t = ti < 3 ? __builtin_amdgcn_exp2f(cbb_t - tab[128 + 32 * (ti + 1)]) : 0.f;
                bf16x8 cfr[8];
#pragma unroll
                for (int k = 0; k < 8; ++k) cfr[k] = *(const LAS bf16x8*)(lds + L_CI + tt * XRS + (16 * k + 8 * hi) * 2);
                f32x16 Y;
#pragma unroll
                for (int r = 0; r < 16; ++r) Y[r] = 0.f;
                for (int si = 0; si < 4; ++si) { f32x16 gacc;
#pragma unroll
                    for (int r = 0; r < 16; ++r) gacc[r] = 0.f;
#pragma unroll
                    for (int k = 0; k < 8; ++k) { const bf16x8 a = *(const LAS bf16x8*)(lds + L_BI + (32 * si + r32) * XRS + (16 * k + 8 * hi) * 2); gacc = __builtin_amdgcn_mfma_f32_32x32x16_bf16(a, cfr[k], gacc, 0, 0, 0); }
                    if (si == ti) {
#pragma unroll
                        for (int r = 0; r < 16; ++r) { const int sidx = 32 * si + crow(r, hi);
                            const float lf = sidx <= tt ? __builtin_amdgcn_exp2f(csf_t - tab[sidx]) * tab[256 + sidx] : 0.f, lb = sidx >= tt ? __builtin_amdgcn_exp2f(cbb_t - tab[128 + sidx]) * tab[384 + sidx] : 0.f;
                            gacc[r] *= (lf + lb); }
                    } else {
                        const float et = si < ti ? ef_t : eb_t; const LAS float* wrow = wtab + (si < ti ? 0 : 512) + ti * 128 + 32 * si + 4 * hi;
#pragma unroll
                        for (int r = 0; r < 16; ++r) gacc[r] *= et * wrow[(r & 3) + 8 * (r >> 2)]; }
#pragma unroll
                    for (int s2 = 0; s2 < 2; ++s2) { u32x4 w;
                        w.x = pg8::cvt_pk_bf16(gacc[8 * s2 + 0], gacc[8 * s2 + 1]); w.y = pg8::cvt_pk_bf16(gacc[8 * s2 + 2], gacc[8 * s2 + 3]); w.z = pg8::cvt_pk_bf16(gacc[8 * s2 + 4], gacc[8 * s2 + 5]); w.w = pg8::cvt_pk_bf16(gacc[8 * s2 + 6], gacc[8 * s2 + 7]);
                        const LAS unsigned char* a0 = lds + L_XT0 + (32 * pt + r32) * XRS + (32 * si + 16 * s2 + 4 * hi) * 2;
                        const u32x2 x0 = *(const LAS u32x2*)a0, x1 = *(const LAS u32x2*)(a0 + 16);
                        Y = __builtin_amdgcn_mfma_f32_32x32x16_bf16(__builtin_bit_cast(bf16x8, u32x4{x0.x, x0.y, x1.x, x1.y}), __builtin_bit_cast(bf16x8, w), Y, 0, 0, 0); } }
#pragma unroll
                for (int dir = 0; dir < 2; ++dir) { f32x16 z;
#pragma unroll
                    for (int r = 0; r < 16; ++r) z[r] = 0.f;
#pragma unroll
                    for (int k = 0; k < 8; ++k) { const bf16x8 a = *(const LAS bf16x8*)(lds + (dir ? L_HB : L_HF) + (32 * pt + r32) * XRS + (16 * k + 8 * hi) * 2); z = __builtin_amdgcn_mfma_f32_32x32x16_bf16(a, cfr[k], z, 0, 0, 0); }
                    const float e = __builtin_amdgcn_exp2f(dir ? cbb_t : csf_t);
#pragma unroll
                    for (int r = 0; r < 16; ++r) Y[r] += e * z[r]; }
                { const float dh = ssd_d_(p)[l * 16 + hh]; float sq = 0.f; bf16* uo = ossd_(p) + (size_t)(row0 + tt) * 1024 + hh * 64 + 32 * pt + 4 * hi; const float* gp = ssd_norm_g_(p) + (size_t)l * 1024 + hh * 64 + 32 * pt + 4 * hi;
#pragma unroll
                    for (int gq = 0; gq < 4; ++gq) { const float4 xv = bf4(xq[gq]), zv = bf4(zq[gq]), gv = *(const float4*)(gp + 8 * gq); float4 v;
                        v.x = (Y[4 * gq] + dh * xv.x) * siluf_(zv.x); v.y = (Y[4 * gq + 1] + dh * xv.y) * siluf_(zv.y); v.z = (Y[4 * gq + 2] + dh * xv.z) * siluf_(zv.z); v.w = (Y[4 * gq + 3] + dh * xv.w) * siluf_(zv.w);
                        sq += f4sq(v); *(uint2*)(uo + 8 * gq) = pk4(float4{v.x * gv.x, v.y * gv.y, v.z * gv.z, v.w * gv.w}); }
                    sq += xshf(sq, 32, lane);
                    if (hi == 0) ssq_(p)[(size_t)(row0 + tt) * 32 + hh * 2 + pt] = sq; }
                __syncthreads();
            } }
        sync();
    }
    __device__ __forceinline__ void ph_mixers(const P& p, int l, int rows) {
        { const int wv = wid; const LAS float* rpbl = (const LAS float*)(lds + att::LB_RPB);
            const int n_na = NB * 8 * 8, n_swa = NB * 2 * 32, n_ctx = rows > TL ? NB * 16 : 0;
#pragma unroll 1
            for (int u = blockIdx.x; u < n_na + n_swa + n_ctx; u += gridDim.x) {
                const unsigned t = tid_(); const int lane = t & 63, hi = lane >> 5, qi = lane & 31;
                att::State st; att::bf16x8 qf[4];
                int type, b, nbatch, qcol, kcol, vcol, hh, gr = 0, qc = 0, c0 = 0, r0 = 0, rlo = 0, rhi = 0, rwlo = 0, rwhi = 0, ws = 0, qp = 0, qhalf = wv & 1; size_t qrow; const bf16* qbase; int qstride; bf16* obase; float m0, l0;
                if (u < n_na) { type = 0; const int rg = u & 7; hh = (u >> 3) & 7; b = u >> 6; nbatch = 3;
                    const int gr0 = 4 * rg + 2 * (wv >> 2), cg = wv & 3; gr = gr0 + (qi >> 4); qc = 16 * cg + (qi & 15); ws = cg == 0 ? 0 : (cg == 1 ? 8 : (cg == 2 ? 24 : 32));
                    qrow = (size_t)b * S + gr * GW + qc - qi;
                    qcol = PC_QN + hh * 64; kcol = PC_KN + hh * 64; vcol = PC_VN + hh * 64; qbase = proj_(p) + qcol; qstride = NPROJ; obase = ona_(p); m0 = -1e30f; l0 = 0.f;
                    r0 = gr - 4 < 0 ? 0 : (gr - 4 > 24 ? 24 : gr - 4); c0 = qc - 8 < 0 ? 0 : (qc - 8 > 48 ? 48 : qc - 8);
                    rwlo = gr0 - 4 < 0 ? 0 : (gr0 - 4 > 24 ? 24 : gr0 - 4); rwhi = (gr0 - 3 < 0 ? 0 : (gr0 - 3 > 24 ? 24 : gr0 - 3)) + 7;
                    rlo = 4 * rg - 4 < 0 ? 0 : (4 * rg - 4 > 24 ? 24 : 4 * rg - 4); rhi = (4 * rg - 1 < 0 ? 0 : (4 * rg - 1 > 24 ? 24 : 4 * rg - 1)) + 7; }
                else if (u < n_na + n_swa) { type = 1; const int v = u - n_na; qp = v & 31; const int kvh = (v >> 5) & 1; b = v >> 6; hh = kvh * 4 + (wv >> 1); qrow = (size_t)b * S + 64 * qp + 32 * qhalf; nbatch = 2;
                    kcol = PC_KS + kvh * 64; vcol = PC_VS + kvh * 64; qcol = hh * 64; qbase = qsr_(p) + qcol; qstride = 512; obase = oswa_(p); m0 = swa_sink_(p)[l * 8 + hh] * att::LOG2E; l0 = lane < 32 ? 1.f : 0.f; }
                else { const int v = u - n_na - n_swa; nbatch = 1; int qt;
                    if (v < NB * 8) { type = 2; const int kvh = (v >> 2) & 1; b = v >> 3; hh = kvh * 4 + (wv >> 1); qt = 2 * (v & 3) + qhalf; qcol = PC_QS + hh * 64; kcol = PC_KS + kvh * 64; vcol = PC_VS + kvh * 64; obase = oswa_(p); m0 = swa_sink_(p)[l * 8 + hh] * att::LOG2E; l0 = lane < 32 ? 1.f : 0.f; }
                    else { type = 3; const int w2 = v - NB * 8; hh = w2 & 7; b = w2 >> 3; qt = wv; qcol = PC_QN + hh * 64; kcol = PC_KN + hh * 64; vcol = PC_VN + hh * 64; obase = ona_(p); m0 = -1e30f; l0 = 0.f; }
                    qrow = (size_t)TL + b * LC + 32 * qt; qbase = proj_(p) + qcol; qstride = NPROJ; }
                att::load_q_at(qf, qbase + (qrow + qi) * qstride, lane); att::init(st, m0, l0);
#pragma unroll 1
                for (int bt = 0; bt < nbatch; ++bt) {
                    const bool is_ctx = bt == nbatch - 1;
                    int nt, rbase, seq_lo; const bf16* kbase; int kstride;
                    if (is_ctx) { nt = 8; rbase = TL + b * LC; seq_lo = rbase; kbase = proj_(p) + kcol; kstride = NPROJ; }
                    else if (type == 0) { const int kr0 = bt == 0 ? rlo : rlo + 6, kr1 = bt == 0 ? (rlo + 5 < rhi ? rlo + 5 : rhi) : rhi; nt = 2 * (kr1 - kr0 + 1); rbase = b * S + kr0 * GW; seq_lo = b * S; kbase = proj_(p) + kcol; kstride = NPROJ; }
                    else { nt = 10; rbase = b * S + 64 * qp - 128; seq_lo = b * S; kbase = ksr_(p) + (kcol - PC_KS); kstride = 128; }
                    const bf16* vbase = proj_(p) + vcol; const int seq_hi = is_ctx ? seq_lo + LC : seq_lo + S;
                    __syncthreads();
                    if (type == 0 && bt == 0) { const float* rpb = na_rpb_(p) + (size_t)(l * 8 + hh) * 15 * 31; if (t < 15 * 31) ((LAS float*)rpbl)[t] = rpb[t] * 8.f; }
                    att::stage_batch(lds, nt, [&](int tl, const bf16*& kp, int& ks, const bf16*& vp, int& vs) { int row = rbase + 32 * tl; row = (row < seq_lo || row >= seq_hi) ? seq_lo : row;
                        kp = kbase + (size_t)row * kstride; ks = kstride; vp = vbase + (size_t)row * NPROJ; vs = NPROJ; }, t);
                    __syncthreads();
                    const bool na_loc = type == 0 && !is_ctx; const int tstep = na_loc ? 2 : 1;
#pragma unroll 1
                    for (int tl = 0; tl < nt; tl += tstep) { int mode = 0, d0 = 0, koff = tl * 32; bool rowok = true; const LAS float* brow2 = rpbl;
                        if (!is_ctx) {
                            if (type == 0) { const int kr = (rbase - b * S) / GW + (tl >> 1); if (kr < rwlo || kr > rwhi) continue; mode = 3; koff += ws; rowok = kr >= r0 && kr < r0 + 8;
                                d0 = ws + 4 * hi - c0; brow2 = rpbl + (kr - gr + 7) * 31 + 15 - qc + ws + 4 * hi; }
                            else { const int row = rbase + 32 * tl, rel = tl - qhalf; if (rel < 0 || rel > 8 || row < seq_lo || row >= seq_hi) continue; mode = rel == 0 ? 1 : (rel == 8 ? 2 : 0); } }
                        if (mode == 3) { float bv[16];
#pragma unroll
                            for (int r = 0; r < 16; ++r) bv[r] = brow2[(r & 3) + 8 * (r >> 2)];
                            att::compute_lds(st, qf, lds, koff, lane, [&](int r, float sv) { return (rowok && (unsigned)(d0 + (r & 3) + 8 * (r >> 2)) < 16u) ? sv + bv[r] : -INFINITY; }); }
                        else if (mode == 1) att::compute_lds(st, qf, lds, koff, lane, [&](int r, float sv) { return (r & 3) + 8 * (r >> 2) + 4 * hi >= qi ? sv : -INFINITY; });
                        else if (mode == 2) att::compute_lds(st, qf, lds, koff, lane, [&](int r, float sv) { return (r & 3) + 8 * (r >> 2) + 4 * hi <= qi ? sv : -INFINITY; });
                        else att::compute_lds(st, qf, lds, koff, lane, att::NoMask{}); }
                }
                att::finish_at(st, obase + (qrow + qi) * 512 + hh * 64, lane);
            }
            __syncthreads(); }
        sync();
        scan_s23(p, l);
    }
    __device__ __forceinline__ void gemm_merge(const P& p, int l, int rows) {
        const unsigned char* g = gate8_(p); const float* bg = b_gate_(p) + (size_t)l * 3 * D;
        const bool split = split_phase(l, rows); const int G = split ? GEMM_WG : 0;
        if (split && (int)blockIdx.x >= GEMM_WG) prep_side(p, sch_merge_lo(l), sch_wout_lo(l));
        gs(ossd_(p), w_ssd_t_(p) + (size_t)l * D * 1024, rows, D, 1024, pg8::EpiMerge<0>{g, bg, macc_(p), m_(p), ssq_(p)}, G);
        gs(oswa_(p), w_swa_t_(p) + (size_t)l * D * 512, rows, D, 512, pg8::EpiMerge<1>{g + 1024, bg + 1024, macc_(p), m_(p), nullptr}, G);
        gs(ona_(p), w_na_t_(p) + (size_t)l * D * 512, rows, D, 512, pg8::EpiMerge<2>{g + 2048, bg + 2048, macc_(p), m_(p), nullptr}, G);
        sync(); }
    __device__ __forceinline__ void gemm_wout(const P& p, int l, int rows, float scale = 1.f) {
        const bool split = split_phase(l, rows);
        if (split && (int)blockIdx.x >= GEMM_WG && scale != 0.f) prep_side(p, sch_wout_lo(l), sch_wout_hi(l));
        gs(m_(p), w_out_t_(p) + (size_t)l * D * D, rows, D, D, pg8::EpiWout{xl_(p), mod_(p) + (size_t)l * (NB + 1) * 6 * D, scale, 0}, split ? GEMM_WG : 0); sync(); }
    __device__ __forceinline__ void ph_norm2(const P& p, int l, int rows, int count = 1) {
        const unsigned t = tid_(); const int lane = t & 63, r = lane & 15, q = lane >> 4, wv = __builtin_amdgcn_readfirstlane(t >> 6), ntile = rows / 16, G = (int)gridDim.x;
        volatile LAS int* hist = (volatile LAS int*)(lds + LDS_CTL_OFF + 256); volatile LAS int* lbase = (volatile LAS int*)(lds + LDS_CTL_OFF + 384);
        const att::bf16x8* whf = (const att::bf16x8*)(n2_wh_(p) + (size_t)l * 32 * 2 * 64 * 8); const att::bf16x8* wlf = (const att::bf16x8*)(n2_wl_(p) + (size_t)l * 32 * 2 * 64 * 8);
#pragma unroll 1
        for (int tb0 = 0; tb0 < ntile; tb0 += 8 * G) {
            const int tile = tb0 + wv * G + (int)blockIdx.x; const bool act = tile < ntile; const int row = tile * 16 + r, mr = act ? mod_row(tile * 16) : 0;
            if (t < NE) hist[t] = 0;
            __syncthreads();
            float rstd = 0.f; int ti[4] = {0, 0, 0, 0}, rk[4] = {0, 0, 0, 0};
            const bf16* xr = (const bf16*)xl_(p) + (size_t)row * D + 8 * q; const float* gm = n2_gm_(p) + (size_t)(l * 9 + mr) * 1024 + 8 * q;
            if (act) {
            pg8::f32x4 acc0 = {0.f, 0.f, 0.f, 0.f}, acc1 = {0.f, 0.f, 0.f, 0.f}; float ssq = 0.f;
#pragma unroll 2
            for (int s2 = 0; s2 < 32; ++s2) { const uint4 xw = *(const uint4*)(xr + 32 * s2); const float4 xa = bf4(uint2{xw.x, xw.y}), xb = bf4(uint2{xw.z, xw.w}), ga = *(const float4*)(gm + 32 * s2), gb = *(const float4*)(gm + 32 * s2 + 4);
                const att::bf16x8 wh0 = whf[(s2 * 2 + 0) * 64 + lane], wh1 = whf[(s2 * 2 + 1) * 64 + lane], wl0 = wlf[(s2 * 2 + 0) * 64 + lane], wl1 = wlf[(s2 * 2 + 1) * 64 + lane];
                ssq += f4sq(xa) + f4sq(xb);
                const float u[8] = {xa.x * ga.x, xa.y * ga.y, xa.z * ga.z, xa.w * ga.w, xb.x * gb.x, xb.y * gb.y, xb.z * gb.z, xb.w * gb.w};
                att::u32x4 uh, ul;
#pragma unroll
                for (int j = 0; j < 4; ++j) { const unsigned hp = pg8::cvt_pk_bf16(u[2 * j], u[2 * j + 1]); uh[j] = hp; ul[j] = pg8::cvt_pk_bf16(u[2 * j] - u2f(hp << 16), u[2 * j + 1] - u2f(hp & 0xffff0000u)); }
                const att::bf16x8 uhf = __builtin_bit_cast(att::bf16x8, uh), ulf = __builtin_bit_cast(att::bf16x8, ul);
                acc0 = __builtin_amdgcn_mfma_f32_16x16x32_bf16(wh0, uhf, acc0, 0, 0, 0); acc1 = __builtin_amdgcn_mfma_f32_16x16x32_bf16(wh1, uhf, acc1, 0, 0, 0);
                acc0 = __builtin_amdgcn_mfma_f32_16x16x32_bf16(wh0, ulf, acc0, 0, 0, 0); acc1 = __builtin_amdgcn_mfma_f32_16x16x32_bf16(wh1, ulf, acc1, 0, 0, 0);
                acc0 = __builtin_amdgcn_mfma_f32_16x16x32_bf16(wl0, uhf, acc0, 0, 0, 0); acc1 = __builtin_amdgcn_mfma_f32_16x16x32_bf16(wl1, uhf, acc1, 0, 0, 0); }
            ssq += xshf(ssq, 16, lane); ssq += xshf(ssq, 32, lane);
            rstd = __builtin_amdgcn_rsqf(ssq * (1.f / D) + NORM_EPS);
            const float* cc = n2_c_(p) + (size_t)(l * 9 + mr) * 32 + 4 * q; const float4 c0 = *(const float4*)cc, c1 = *(const float4*)(cc + 16);
            float lg[8] = {rstd * acc0[0] + c0.x, rstd * acc0[1] + c0.y, rstd * acc0[2] + c0.z, rstd * acc0[3] + c0.w, rstd * acc1[0] + c1.x, rstd * acc1[1] + c1.y, rstd * acc1[2] + c1.z, rstd * acc1[3] + c1.w};
            float tv[4];
#pragma unroll
            for (int k = 0; k < 4; ++k) { float bv = lg[0]; int bi = 0;
#pragma unroll
                for (int i = 1; i < 8; ++i) { const bool g2 = lg[i] > bv; bv = g2 ? lg[i] : bv; bi = g2 ? i : bi; }
                int be = (bi < 4 ? 4 * q + bi : 16 + 4 * q + (bi - 4));
#pragma unroll
                for (int o = 16; o < 64; o <<= 1) { const float ov = xshf(bv, o, lane); const int oe = xshi(be, o, lane); const bool tk = ov > bv || (ov == bv && oe < be); bv = tk ? ov : bv; be = tk ? oe : be; }
                tv[k] = bv; ti[k] = be;
#pragma unroll
                for (int i = 0; i < 8; ++i) { const int ei = (i < 4 ? 4 * q + i : 16 + 4 * q + (i - 4)); lg[i] = ei == be ? -3e38f : lg[i]; } }
            if (q == 0) { const float e1 = fexp_(tv[1] - tv[0]), e2 = fexp_(tv[2] - tv[0]), e3 = fexp_(tv[3] - tv[0]), inv = 1.f / (1.f + e1 + e2 + e3);
                *(float4*)(topw_(p) + row * 4) = float4{inv, e1 * inv, e2 * inv, e3 * inv};
                if (count) {
#pragma unroll
                    for (int k = 0; k < 4; ++k) rk[k] = __hip_atomic_fetch_add((LAS int*)&hist[ti[k]], 1, __ATOMIC_RELAXED, __HIP_MEMORY_SCOPE_WORKGROUP); } }
            }
            __syncthreads();
            int gbase = 0; if (t < NE && count) { const int c = hist[t]; gbase = c ? atomicAdd(cursor_(p) + t * 32, c) : 0; }
            if (act) {
            const float* sh = mod_ptr(p, l, row, 3) + 8 * q; unsigned char* ho = h8_(p) + (size_t)row * D + 8 * q;
#pragma unroll 4
            for (int s2 = 0; s2 < 32; ++s2) { const uint4 xw = *(const uint4*)(xr + 32 * s2); const float4 xa = bf4(uint2{xw.x, xw.y}), xb = bf4(uint2{xw.z, xw.w}), ga = *(const float4*)(gm + 32 * s2), gb = *(const float4*)(gm + 32 * s2 + 4), sa = *(const float4*)(sh + 32 * s2), sb = *(const float4*)(sh + 32 * s2 + 4);
                int lo = __builtin_amdgcn_cvt_pk_fp8_f32(xa.x * rstd * ga.x + sa.x, xa.y * rstd * ga.y + sa.y, 0, false); lo = __builtin_amdgcn_cvt_pk_fp8_f32(xa.z * rstd * ga.z + sa.z, xa.w * rstd * ga.w + sa.w, lo, true);
                int hi2 = __builtin_amdgcn_cvt_pk_fp8_f32(xb.x * rstd * gb.x + sb.x, xb.y * rstd * gb.y + sb.y, 0, false); hi2 = __builtin_amdgcn_cvt_pk_fp8_f32(xb.z * rstd * gb.z + sb.z, xb.w * rstd * gb.w + sb.w, hi2, true);
                *(uint2*)(ho + 32 * s2) = uint2{(unsigned)lo, (unsigned)hi2}; } }
            if (t < NE) lbase[t] = gbase;
            __syncthreads();
            if (act && q == 0 && count) { int so[4];
#pragma unroll
                for (int k = 0; k < 4; ++k) { const int rank = lbase[ti[k]] + rk[k]; stok2_(p)[ti[k] * TT + rank] = row; so[k] = (ti[k] << 20) | rank; }
                *(int4*)(slot_of_(p) + row * 4) = int4{so[0], so[1], so[2], so[3]}; }
        }
        sync();
    }
    __device__ __forceinline__ void ph_moe_plan(const P&, int, int) {}
    __device__ __forceinline__ void gemm_moe1(const P& p, int l) { moe_tables(p); gt<true, 122, 127>(h8_(p), w1_8_(p) + (size_t)l * NE * 2048 * D, D / 2, 3, stok2_(p), true, pg8::EpiMoe1F8{act8_(p), moe_b1_(p) + (size_t)l * NE * 2048}); sync(); }
    __device__ __forceinline__ void gemm_moe2(const P& p, int l) { gt<true, 122, 125>(act8_(p), w2_8_(p) + (size_t)l * NE * D * D, D / 2, 2, ident_(p), false, pg8::EpiMoe2{ys_(p), moe_b2_(p) + (size_t)l * NE * D}); sync(); }
    __device__ __forceinline__ void ph_final(const P& p) {
        const unsigned t = tid_(); const int lane = t & 63, gw = blockIdx.x * 8 + __builtin_amdgcn_readfirstlane(t >> 6), ngw = gridDim.x * 8;
        for (int r = gw; r < TL; r += 2 * ngw) { const int rr[2] = {r, r + ngw < TL ? r + ngw : r};
            float4 v[2][4];
#pragma unroll
            for (int q = 0; q < 2; ++q)
#pragma unroll
                for (int j = 0; j < 4; ++j) v[q][j] = bf4(*(const uint2*)((const bf16*)xl_(p) + (size_t)rr[q] * D + (j * 64 + lane) * 4));
#pragma unroll
            for (int q = 0; q < 2; ++q) dev_combine(p, NL - 1, rr[q], lane, v[q]);
#pragma unroll
            for (int q = 0; q < 2; ++q) { const float rstd = __builtin_amdgcn_rsqf(wave_sum((f4sq(v[q][0]) + f4sq(v[q][1])) + (f4sq(v[q][2]) + f4sq(v[q][3])), lane) * (1.f / D) + NORM_EPS);
#pragma unroll
                for (int j = 0; j < 4; ++j) { const int idx = (j * 64 + lane) * 4; const float4 g = *(const float4*)(final_g_(p) + idx);
                    *(float4*)(p.out + (size_t)rr[q] * D + idx) = float4{v[q][j].x * rstd * g.x, v[q][j].y * rstd * g.y, v[q][j].z * rstd * g.z, v[q][j].w * rstd * g.w}; } } }
    }
};

__global__ void __launch_bounds__(NTHR, 2) mega_fwd(P p) {
    extern __shared__ __attribute__((aligned(16))) unsigned char lds_raw[];
    LAS unsigned char* lds = (LAS unsigned char*)lds_raw;
    volatile LAS unsigned* ctlw = (volatile LAS unsigned*)(lds + LDS_CTL_OFF);
    if (threadIdx.x < 64) ctlw[threadIdx.x] = 0u;
    __syncthreads();
    MegaEx ex{lds, xcd_barrier_post(ctl_(p) + 4096, ctlw + 8), __builtin_amdgcn_readfirstlane((int)(threadIdx.x >> 6))};
    forward(ex, p);
}

extern "C" void kernel_launch(void* const* d_in, const int* in_sizes, int n_in, void* d_out, int out_size, void* d_ws, size_t ws_size, hipStream_t stream) {
    static int grid = 0;
    P p{}; bind_inputs(p, d_in, d_out, d_ws);
    const size_t need = WS_TOTAL;
    if (grid == 0) {
        if (n_in != 29 || need > ws_size) { fprintf(stderr, "kernel_launch: need %zu bytes of workspace, have %zu (n_in %d)\n", need, ws_size, n_in); grid = -1; return; }
        int dev = 0, cus = 0, per_cu = 0;
        if (hipGetDevice(&dev) != hipSuccess || hipDeviceGetAttribute(&cus, hipDeviceAttributeMultiprocessorCount, dev) != hipSuccess) { grid = -1; return; }
        if (hipFuncSetAttribute((const void*)mega_fwd, hipFuncAttributeMaxDynamicSharedMemorySize, LDS_BYTES) != hipSuccess) { fprintf(stderr, "kernel_launch: hipFuncSetAttribute failed\n"); grid = -1; return; }
        if (hipOccupancyMaxActiveBlocksPerMultiprocessor(&per_cu, (const void*)mega_fwd, NTHR, LDS_BYTES) != hipSuccess || per_cu < 1) { fprintf(stderr, "kernel_launch: occupancy query says %d blocks per CU\n", per_cu); (void)hipGetLastError(); grid = -1; return; }
        grid = cus;
    }
    if (grid < 0) return;
    (void)hipMemsetAsync(ctl_(p), 0, 1 << 20, stream);
    hipLaunchKernelGGL(mega_fwd, dim3(grid), dim3(NTHR), LDS_BYTES, stream, p);
}
#endif
```
